# Optimizing an MI355X kernel written in HIP

```python
import jax, jax.numpy as jnp
from jax import lax
import numpy as np

D_MODEL = 1024
BATCH = 2
SEQ = 16384
DEPTH = 2

RWKV_HEADS = 8
RWKV_HEAD_DIM = 64
RWKV_WIDTH = RWKV_HEADS * RWKV_HEAD_DIM
DECAY_LORA = 64
AAA_LORA = 64
GATE_LORA = 128
RWKV_GN_EPS = 64e-5
RWKV_COLS = 3 * RWKV_WIDTH + DECAY_LORA + AAA_LORA + GATE_LORA
CONF_WIDTH = 256
CONF_CONV_WIDTH = 31
CONF_COLS = 2 * CONF_WIDTH
SHORT_WIDTH = 256
SHORT_CONV_WIDTH = 3
SHORT_COLS = 3 * SHORT_WIDTH
N_BRANCHES = 3
GATE_COLS = N_BRANCHES * D_MODEL
IN_COLS = RWKV_COLS + CONF_COLS + SHORT_COLS + GATE_COLS
D_FF = 2816
N_EXPERTS = 8
TOP_K = 2
EXPERT_FF = 2816
MOE_BLOCK = 256
LN_EPS = 1e-5

kernel_name = "hybrid_rwkv7_conformer_shortconv_moe_deepnorm"


def _layernorm(x, g, b, eps=LN_EPS):
    xf = x.astype(jnp.float32)
    mu = jnp.mean(xf, axis=-1, keepdims=True)
    var = jnp.mean(jnp.square(xf - mu), axis=-1, keepdims=True)
    return ((xf - mu) * lax.rsqrt(var + eps) * g + b).astype(x.dtype)


def _causal_depthwise_conv(x, w):
    width, ch = w.shape
    return lax.conv_general_dilated(
        x, w[:, None, :].astype(x.dtype), window_strides=(1,), padding=[(width - 1, 0)],
        dimension_numbers=("NWC", "WIO", "NWC"), feature_group_count=ch)


def _rwkv7_scan(r, decay, k, v, kk, a):
    bn, _, h, n = r.shape

    def step(state, inp):
        r_t, w_t, k_t, v_t, kk_t, a_t = inp
        sa = jnp.einsum("bhvk,bhk->bhv", state, -kk_t)
        state = (state * w_t[:, :, None, :]
                 + sa[..., None] * (kk_t * a_t)[:, :, None, :]
                 + v_t[..., None] * k_t[:, :, None, :])
        out = jnp.einsum("bhvk,bhk->bhv", state, r_t)
        return state, out

    xs = tuple(jnp.moveaxis(t, 1, 0) for t in (r, decay, k, v, kk, a))
    s0 = jnp.zeros((bn, h, n, n), jnp.float32)
    _, out = lax.scan(step, s0, xs)
    return jnp.moveaxis(out, 0, 1)


def _rwkv7_branch(p, mu, w0, w2, a0, a2, g2, k_k, k_a, r_k, ln_g, ln_b, w_o):
    bn, s, _ = p.shape
    H, N, W = RWKV_HEADS, RWKV_HEAD_DIM, RWKV_WIDTH
    f32 = jnp.float32
    p_prev = jnp.pad(p, ((0, 0), (1, 0), (0, 0)))[:, :-1]
    p = p + (p_prev - p) * mu
    cuts = [W, 2 * W, 3 * W, 3 * W + DECAY_LORA, 3 * W + DECAY_LORA + AAA_LORA]
    r, k, v, pw, pa, pg = jnp.split(p, cuts, axis=-1)
    w = -jax.nn.softplus(-(w0 + jnp.tanh(pw) @ w2).astype(f32)) - 0.5
    decay = jnp.exp(-jnp.exp(w))
    a = jax.nn.sigmoid((a0 + pa @ a2).astype(f32))
    g = jax.nn.sigmoid(pg) @ g2
    heads = lambda t: t.reshape(bn, s, H, N)
    k = k.astype(f32)
    kk = heads(k * k_k)
    kk = kk / jnp.maximum(jnp.sqrt(jnp.sum(kk * kk, axis=-1, keepdims=True)), 1e-12)
    k = k * (1.0 + (a - 1.0) * k_a)
    r4, k4, v4 = heads(r.astype(f32)), heads(k), heads(v.astype(f32))
    o = _rwkv7_scan(r4, heads(decay), k4, v4, kk, heads(a))
    mean = jnp.mean(o, axis=-1, keepdims=True)
    var = jnp.mean(jnp.square(o - mean), axis=-1, keepdims=True)
    o = (o - mean) * lax.rsqrt(var + RWKV_GN_EPS) * ln_g.reshape(H, N) + ln_b.reshape(H, N)
    o = o + jnp.sum(r4 * k4 * r_k, axis=-1, keepdims=True) * v4
    o = (o.reshape(bn, s, W) * g).astype(p.dtype)
    return o @ w_o


def _conformer_conv_branch(p, dw, dw_b, ln_g, ln_b, w_o):
    u = p[..., :CONF_WIDTH] * jax.nn.sigmoid(p[..., CONF_WIDTH:])
    u = _causal_depthwise_conv(u, dw) + dw_b
    u = jax.nn.silu(_layernorm(u, ln_g, ln_b))
    return u @ w_o


def _short_conv_branch(p, dw, w_o):
    gb, gc, h = jnp.split(p, 3, axis=-1)
    return (gb * _causal_depthwise_conv(gc * h, dw)) @ w_o


def _hybrid_mixer(x, w_in, rwkv_mu, rwkv_w0, rwkv_w2, rwkv_a0, rwkv_a2, rwkv_g2, rwkv_k_k,
                  rwkv_k_a, rwkv_r_k, rwkv_ln_g, rwkv_ln_b, rwkv_w_o, conf_dw, conf_dw_b,
                  conf_ln_g, conf_ln_b, conf_w_o, short_dw, short_w_o, w_out):
    p = x @ w_in
    c1 = RWKV_COLS
    c2 = c1 + CONF_COLS
    c3 = c2 + SHORT_COLS
    p_rwkv, p_conf, p_short, p_gate = jnp.split(p, [c1, c2, c3], axis=-1)
    y_a = _rwkv7_branch(p_rwkv, rwkv_mu, rwkv_w0, rwkv_w2, rwkv_a0, rwkv_a2, rwkv_g2,
                        rwkv_k_k, rwkv_k_a, rwkv_r_k, rwkv_ln_g, rwkv_ln_b, rwkv_w_o)
    y_b = _conformer_conv_branch(p_conf, conf_dw, conf_dw_b, conf_ln_g, conf_ln_b, conf_w_o)
    y_c = _short_conv_branch(p_short, short_dw, short_w_o)
    g_a, g_b, g_c = jnp.split(jax.nn.sigmoid(p_gate), N_BRANCHES, axis=-1)
    return (g_a * y_a.astype(x.dtype) + g_b * y_b + g_c * y_c) @ w_out


def _swiglu(x, w_gate, w_up, w_down):
    return (jax.nn.silu(x @ w_gate) * (x @ w_up)) @ w_down


def _moe_swiglu(x, w_router, w_gate, w_up, w_down):
    bn, s, d = x.shape
    xf = x.reshape(-1, d)
    n_tok = xf.shape[0]
    logits = (xf @ w_router).astype(jnp.float32)
    top_logit, top_idx = lax.top_k(logits, TOP_K)
    top_w = jax.nn.softmax(top_logit, axis=-1)
    n_assign = n_tok * TOP_K
    expert = top_idx.reshape(-1).astype(jnp.int32)
    token = jnp.repeat(jnp.arange(n_tok, dtype=jnp.int32), TOP_K)
    weight = top_w.reshape(-1)
    order = jnp.argsort(expert)
    s_expert, s_token, s_weight = expert[order], token[order], weight[order]
    counts = jnp.bincount(expert, length=N_EXPERTS).astype(jnp.int32)
    starts = jnp.cumsum(counts) - counts
    padded = ((counts + MOE_BLOCK - 1) // MOE_BLOCK) * MOE_BLOCK
    pad_ends = jnp.cumsum(padded)
    pad_starts = pad_ends - padded
    rank = jnp.arange(n_assign, dtype=jnp.int32) - starts[s_expert]
    dest = pad_starts[s_expert] + rank
    n_rows = (-(-n_assign // MOE_BLOCK) + N_EXPERTS) * MOE_BLOCK
    n_blocks = n_rows // MOE_BLOCK
    row_token = jnp.zeros((n_rows,), jnp.int32).at[dest].set(s_token)
    row_weight = jnp.zeros((n_rows,), jnp.float32).at[dest].set(s_weight)
    block_start = jnp.arange(n_blocks, dtype=jnp.int32) * MOE_BLOCK
    block_expert = jnp.minimum(jnp.searchsorted(pad_ends, block_start, side="right"),
                               N_EXPERTS - 1)
    xb = xf[row_token].reshape(n_blocks, MOE_BLOCK, d)

    def expert_block(args):
        xs, e = args
        return (jax.nn.silu(xs @ w_gate[e]) * (xs @ w_up[e])) @ w_down[e]

    yb = lax.map(expert_block, (xb, block_expert))
    y_rows = yb.reshape(n_rows, d) * row_weight[:, None].astype(x.dtype)
    out = jnp.zeros_like(xf).at[row_token].add(y_rows)
    return out.reshape(bn, s, d)


def setup_inputs(seed: int = 0) -> dict:
    key = jax.random.key(seed)
    ks = jax.random.split(key, 40)
    L = DEPTH
    n_dense = (DEPTH + 1) // 2
    n_moe = DEPTH // 2
    beta = (8.0 * DEPTH) ** -0.25
    D, W = D_MODEL, RWKV_WIDTH

    def nrm(k, shape, scale):
        return jax.random.normal(k, shape, jnp.float32) * scale

    w0_base = -6.0 + 5.0 * (jnp.arange(W, dtype=jnp.float32) / (W - 1)) ** 0.9
    return {
        "x": nrm(ks[0], (BATCH, SEQ, D), 1.0),
        "w_in": nrm(ks[1], (L, D, IN_COLS), D ** -0.5),
        "rwkv_mu": jax.random.uniform(ks[2], (L, RWKV_COLS), jnp.float32),
        "rwkv_w0": w0_base + nrm(ks[3], (L, W), 0.1),
        "rwkv_w2": nrm(ks[4], (L, DECAY_LORA, W), 0.1 * DECAY_LORA ** -0.5),
        "rwkv_a0": nrm(ks[5], (L, W), 0.1),
        "rwkv_a2": nrm(ks[6], (L, AAA_LORA, W), AAA_LORA ** -0.5),
        "rwkv_g2": nrm(ks[7], (L, GATE_LORA, W), GATE_LORA ** -0.5),
        "rwkv_k_k": 0.85 + nrm(ks[8], (L, W), 0.02),
        "rwkv_k_a": 1.0 + nrm(ks[9], (L, W), 0.02),
        "rwkv_r_k": nrm(ks[10], (L, RWKV_HEADS, RWKV_HEAD_DIM), 0.1),
        "rwkv_ln_g": 1.0 + nrm(ks[11], (L, W), 0.02),
        "rwkv_ln_b": nrm(ks[12], (L, W), 0.02),
        "rwkv_w_o": nrm(ks[13], (L, W, D), W ** -0.5),
        "conf_dw": nrm(ks[14], (L, CONF_CONV_WIDTH, CONF_WIDTH), CONF_CONV_WIDTH ** -0.5),
        "conf_dw_b": nrm(ks[15], (L, CONF_WIDTH), 0.02),
        "conf_ln_g": 1.0 + nrm(ks[16], (L, CONF_WIDTH), 0.02),
        "conf_ln_b": nrm(ks[17], (L, CONF_WIDTH), 0.02),
        "conf_w_o": nrm(ks[18], (L, CONF_WIDTH, D), CONF_WIDTH ** -0.5),
        "short_dw": nrm(ks[19], (L, SHORT_CONV_WIDTH, SHORT_WIDTH), SHORT_CONV_WIDTH ** -0.5),
        "short_w_o": nrm(ks[20], (L, SHORT_WIDTH, D), SHORT_WIDTH ** -0.5),
        "w_out": nrm(ks[21], (L, D, D), beta * D ** -0.5),
        "ln1_g": 1.0 + nrm(ks[22], (L, D), 0.02),
        "ln1_b": nrm(ks[23], (L, D), 0.02),
        "ffn_w_gate": nrm(ks[24], (n_dense, D, D_FF), D ** -0.5),
        "ffn_w_up": nrm(ks[25], (n_dense, D, D_FF), D ** -0.5),
        "ffn_w_down": nrm(ks[26], (n_dense, D_FF, D), beta * D_FF ** -0.5),
        "moe_router": nrm(ks[27], (n_moe, D, N_EXPERTS), D ** -0.5),
        "moe_w_gate": nrm(ks[28], (n_moe, N_EXPERTS, D, EXPERT_FF), D ** -0.5),
        "moe_w_up": nrm(ks[29], (n_moe, N_EXPERTS, D, EXPERT_FF), D ** -0.5),
        "moe_w_down": nrm(ks[30], (n_moe, N_EXPERTS, EXPERT_FF, D), beta * EXPERT_FF ** -0.5),
        "ln2_g": 1.0 + nrm(ks[31], (L, D), 0.02),
        "ln2_b": nrm(ks[32], (L, D), 0.02),
    }


def reference(x, w_in, rwkv_mu, rwkv_w0, rwkv_w2, rwkv_a0, rwkv_a2, rwkv_g2, rwkv_k_k,
              rwkv_k_a, rwkv_r_k, rwkv_ln_g, rwkv_ln_b, rwkv_w_o, conf_dw, conf_dw_b,
              conf_ln_g, conf_ln_b, conf_w_o, short_dw, short_w_o, w_out, ln1_g, ln1_b,
              ffn_w_gate, ffn_w_up, ffn_w_down, moe_router, moe_w_gate, moe_w_up,
              moe_w_down, ln2_g, ln2_b):
    alpha = (2.0 * DEPTH) ** 0.25
    for i in range(DEPTH):
        mix = _hybrid_mixer(x, w_in[i], rwkv_mu[i], rwkv_w0[i], rwkv_w2[i], rwkv_a0[i],
                            rwkv_a2[i], rwkv_g2[i], rwkv_k_k[i], rwkv_k_a[i], rwkv_r_k[i],
                            rwkv_ln_g[i], rwkv_ln_b[i], rwkv_w_o[i], conf_dw[i], conf_dw_b[i],
                            conf_ln_g[i], conf_ln_b[i], conf_w_o[i], short_dw[i],
                            short_w_o[i], w_out[i])
        x = _layernorm(alpha * x + mix, ln1_g[i], ln1_b[i])
        j = i // 2
        if i % 2 == 0:
            f = _swiglu(x, ffn_w_gate[j], ffn_w_up[j], ffn_w_down[j])
        else:
            f = _moe_swiglu(x, moe_router[j], moe_w_gate[j], moe_w_up[j], moe_w_down[j])
        x = _layernorm(alpha * x + f, ln2_g[i], ln2_b[i])
    return x
```

```cpp
#include <hip/hip_runtime.h>
#include <cstdio>
#include <cstdint>
namespace pg8 {
#define PG8_LAS __attribute__((address_space(3)))
typedef unsigned short bf16_t;
typedef short bf16x8 __attribute__((ext_vector_type(8)));
typedef float f32x4 __attribute__((ext_vector_type(4)));
typedef unsigned u32x4 __attribute__((ext_vector_type(4)));
typedef unsigned u32x2 __attribute__((ext_vector_type(2)));
constexpr int BM = 256, BK = 64, HALF = 128, HTB = HALF * BK * 2  , STAGE_BYTES = 8 * HTB, NXCD = 8, WGM = 8;

__host__ __device__ __forceinline__ int lds_byte(int r, int c) { const int st = (r >> 4) * 2 + (c >> 5), rr = r & 15, cc = c & 31, ob = rr * 64 + cc * 2; return st * 1024 + (ob ^ (((ob >> 9) & 1) << 5)); }
__host__ __device__ __forceinline__ void stage_rc(int b, int& R, int& C) { const int st = b / 1024, sb = b % 1024, swz = sb ^ (((sb >> 9) & 1) << 5); R = (st >> 1) * 16 + swz / 64; C = (st & 1) * 32 + (swz % 64) / 2; }
__host__ __device__ __forceinline__ int perm32(int rho) { const int n = rho >> 4, i = rho & 15; return 8 * (i >> 2) + 4 * n + (i & 3); }

struct Unit { int pm, pn, pb; };
struct Gemm { const bf16_t* A; const bf16_t* Bt; int M, N, K; };

struct StaticOrder {
    int nM, nN, nwg, G, c;
    __host__ __device__ void init(int M, int N, int G_, int c_) { nM = M / BM; nN = N / BM; nwg = nM * nN; G = G_; c = c_; }
    __host__ __device__ bool next(int i, Unit& u) const {
        const long L = (long)i * G + c; if (L >= nwg) return false;
        int wgid = (int)L; { const int q = nwg / NXCD, r = nwg % NXCD, xcd = wgid % NXCD, off = wgid / NXCD; wgid = (xcd < r ? xcd * (q + 1) : r * (q + 1) + (xcd - r) * q) + off; }
        const int nig = WGM * nN, gid = wgid / nig, fm = gid * WGM, gsz = (nM - fm) < WGM ? (nM - fm) : WGM;
        u.pm = fm + ((wgid % nig) % gsz); u.pn = (wgid % nig) / gsz; u.pb = u.pn; return true;
    }
    __device__ __forceinline__ void a_ready(const Unit&) const {}
    __device__ __forceinline__ void done(const Unit&) const {}
};
struct MoeOrder : StaticOrder {
    int blk0; const int* blke;
    __device__ __forceinline__ bool next(int i, Unit& u) const {
        if (!StaticOrder::next(i, u)) return false;
        u.pm += blk0; u.pb = blke[u.pm] * nN + u.pn; return true;
    }
};

__device__ __forceinline__ unsigned cvt_pk_bf16(float lo, float hi) { unsigned r; asm volatile("v_cvt_pk_bf16_f32 %0, %1, %2" : "=v"(r) : "v"(lo), "v"(hi)); return r; }
__device__ __forceinline__ float sigm(float x) { return __builtin_amdgcn_rcpf(1.f + __builtin_amdgcn_exp2f(-1.44269504f * x)); }
__device__ __forceinline__ float bflo(unsigned w) { return __uint_as_float(w << 16); }
__device__ __forceinline__ float bfhi(unsigned w) { return __uint_as_float(w & 0xffff0000u); }

#define PG8_ROWS(ai, m) for (int ai = 0; ai < 2; ++ai) _Pragma("unroll") for (int m = 0; m < 4; ++m)

struct EpiBf16 {
    static constexpr bool PERM = true, AFTER_DRAIN = false;
    bf16_t* O; int ldc;
    __device__ __forceinline__ void operator()(const f32x4 (&acc)[2][2][4][2], const Unit& u, int wr, int wc, int fr, int fq) const {
        const int row0 = u.pm * BM + wr * 64 + fr, col0 = u.pn * BM + wc * 32 + 8 * fq;
#pragma unroll
        PG8_ROWS(ai, m) { bf16_t* rowp = O + (size_t)(row0 + ai * HALF + m * 16) * ldc + col0;
#pragma unroll
            for (int bj = 0; bj < 2; ++bj) { const f32x4 v0 = acc[ai][bj][m][0], v1 = acc[ai][bj][m][1];
                u32x4 w; w.x = cvt_pk_bf16(v0[0], v0[1]); w.y = cvt_pk_bf16(v0[2], v0[3]); w.z = cvt_pk_bf16(v1[0], v1[1]); w.w = cvt_pk_bf16(v1[2], v1[3]);
                *(u32x4*)(rowp + bj * HALF) = w; } }
    }
};
struct EpiPG {
    static constexpr bool PERM = true, AFTER_DRAIN = false;
    bf16_t* P; bf16_t* G;
    __device__ __forceinline__ void operator()(const f32x4 (&acc)[2][2][4][2], const Unit& u, int wr, int wc, int fr, int fq) const {
        const int row0 = u.pm * BM + wr * 64 + fr; int colt = u.pn * BM; const bool isg = colt >= 3072; bf16_t* base = isg ? G : P; if (isg) colt -= 3072;
        const int col0 = colt + wc * 32 + 8 * fq;
#pragma unroll
        PG8_ROWS(ai, m) { bf16_t* rowp = base + (size_t)(row0 + ai * HALF + m * 16) * 3072 + col0;
#pragma unroll
            for (int bj = 0; bj < 2; ++bj) { f32x4 v0 = acc[ai][bj][m][0], v1 = acc[ai][bj][m][1];
                if (isg) {
#pragma unroll
                    for (int j = 0; j < 4; ++j) { v0[j] = sigm(v0[j]); v1[j] = sigm(v1[j]); } }
                u32x4 w; w.x = cvt_pk_bf16(v0[0], v0[1]); w.y = cvt_pk_bf16(v0[2], v0[3]); w.z = cvt_pk_bf16(v1[0], v1[1]); w.w = cvt_pk_bf16(v1[2], v1[3]);
                *(u32x4*)(rowp + bj * HALF) = w; } }
    }
};
struct EpiLora {
    static constexpr bool PERM = true, AFTER_DRAIN = false;
    float* LD; bf16_t* AA; long gg_off; const float* w0; const float* a0;
    __device__ __forceinline__ void operator()(const f32x4 (&acc)[2][2][4][2], const Unit& u, int wr, int wc, int fr, int fq) const {
        const int row0 = u.pm * BM + wr * 64 + fr; const int kind = u.pn >> 1; const int col0 = (u.pn & 1) * BM + wc * 32 + 8 * fq;
        const float* bias = (kind == 0 ? w0 : a0) + col0; const float bs = kind == 2 ? 0.f : 1.f;
#pragma unroll
        PG8_ROWS(ai, m) { const size_t ro = (size_t)(row0 + ai * HALF + m * 16) * 512 + col0;
#pragma unroll
            for (int bj = 0; bj < 2; ++bj) { f32x4 v0 = acc[ai][bj][m][0] + *(const f32x4*)(bias + bj * HALF) * bs, v1 = acc[ai][bj][m][1] + *(const f32x4*)(bias + bj * HALF + 4) * bs;
                if (kind == 0) {
#pragma unroll
                    for (int j = 0; j < 4; ++j) {
                        { const float y = -v0[j]; const float sp = fmaxf(y, 0.f) + __logf(1.f + __expf(-fabsf(y))); v0[j] = -__expf(-sp - 0.5f); }
                        { const float y = -v1[j]; const float sp = fmaxf(y, 0.f) + __logf(1.f + __expf(-fabsf(y))); v1[j] = -__expf(-sp - 0.5f); } }
                    *(f32x4*)(LD + ro + bj * HALF) = v0; *(f32x4*)(LD + ro + bj * HALF + 4) = v1;
                } else {
                    if (kind == 1) {
#pragma unroll
                        for (int j = 0; j < 4; ++j) { v0[j] = sigm(v0[j]); v1[j] = sigm(v1[j]); } }
                    u32x4 w; w.x = cvt_pk_bf16(v0[0], v0[1]); w.y = cvt_pk_bf16(v0[2], v0[3]); w.z = cvt_pk_bf16(v1[0], v1[1]); w.w = cvt_pk_bf16(v1[2], v1[3]);
                    *(u32x4*)(AA + (kind == 1 ? 0l : gg_off) + ro + bj * HALF) = w; } }
            asm volatile("" ::: "memory"); }
    }
};
template <int MODE> struct EpiMerge {
    static constexpr bool PERM = true, AFTER_DRAIN = false;
    const bf16_t* G; int gcol0; float* MRG; bf16_t* MRGB;
    __device__ __forceinline__ void operator()(const f32x4 (&acc)[2][2][4][2], const Unit& u, int wr, int wc, int fr, int fq) const {
        const int row0 = u.pm * BM + wr * 64 + fr, col0 = u.pn * BM + wc * 32 + 8 * fq;
#pragma unroll
        PG8_ROWS(ai, m) { const size_t row = (size_t)(row0 + ai * HALF + m * 16);
#pragma unroll
            for (int bj = 0; bj < 2; ++bj) { const int col = col0 + bj * HALF;
                const u32x4 gw = *(const u32x4*)(G + row * 3072 + gcol0 + col);
                f32x4 v0 = acc[ai][bj][m][0], v1 = acc[ai][bj][m][1];
                v0[0] *= bflo(gw.x); v0[1] *= bfhi(gw.x); v0[2] *= bflo(gw.y); v0[3] *= bfhi(gw.y); v1[0] *= bflo(gw.z); v1[1] *= bfhi(gw.z); v1[2] *= bflo(gw.w); v1[3] *= bfhi(gw.w);
                float* mp = MRG + row * 1024 + col;
                if (MODE >= 1) { v0 += *(const f32x4*)mp; v1 += *(const f32x4*)(mp + 4); }
                if (MODE <= 1) { *(f32x4*)mp = v0; *(f32x4*)(mp + 4) = v1; }
                else { u32x4 w; w.x = cvt_pk_bf16(v0[0], v0[1]); w.y = cvt_pk_bf16(v0[2], v0[3]); w.z = cvt_pk_bf16(v1[0], v1[1]); w.w = cvt_pk_bf16(v1[2], v1[3]); *(u32x4*)(MRGB + row * 1024 + col) = w; } } }
    }
};
struct EpiResid {
    static constexpr bool PERM = false, AFTER_DRAIN = false;
    const float* src; float* out; float alpha;
    __device__ __forceinline__ void operator()(const f32x4 (&acc)[2][2][4][2], const Unit& u, int wr, int wc, int fr, int fq) const {
        const int row0 = u.pm * BM + wr * 64 + fr, col0 = u.pn * BM + wc * 32 + 4 * fq;
#pragma unroll
        PG8_ROWS(ai, m) { const size_t off = (size_t)(row0 + ai * HALF + m * 16) * 1024 + col0;
#pragma unroll
            for (int bj = 0; bj < 2; ++bj)
#pragma unroll
                for (int n = 0; n < 2; ++n) { const f32x4 s = *(const f32x4*)(src + off + bj * HALF + n * 16); *(f32x4*)(out + off + bj * HALF + n * 16) = s * alpha + acc[ai][bj][m][n]; } }
    }
};
struct EpiSwiglu {
    static constexpr bool PERM = true, AFTER_DRAIN = false;
    bf16_t* H; int ldc;
    __device__ __forceinline__ void operator()(const f32x4 (&acc)[2][2][4][2], const Unit& u, int wr, int wc, int fr, int fq) const {
        const int row0 = u.pm * BM + wr * 64 + fr, col0 = u.pn * HALF + wc * 32 + 8 * fq;
#pragma unroll
        PG8_ROWS(ai, m) { bf16_t* rowp = H + (size_t)(row0 + ai * HALF + m * 16) * ldc + col0;
            f32x4 v0 = acc[ai][0][m][0], v1 = acc[ai][0][m][1]; const f32x4 u0 = acc[ai][1][m][0], u1 = acc[ai][1][m][1];
#pragma unroll
            for (int j = 0; j < 4; ++j) { v0[j] = v0[j] * sigm(v0[j]) * u0[j]; v1[j] = v1[j] * sigm(v1[j]) * u1[j]; }
            u32x4 w; w.x = cvt_pk_bf16(v0[0], v0[1]); w.y = cvt_pk_bf16(v0[2], v0[3]); w.z = cvt_pk_bf16(v1[0], v1[1]); w.w = cvt_pk_bf16(v1[2], v1[3]);
            *(u32x4*)rowp = w; }
    }
};
template <class Epi, class Sched, bool ALIGN_EPI = false, bool SP2 = false>
__device__ __forceinline__ void gemm_phase(PG8_LAS unsigned char* lds, const Gemm g, const Sched& S, const Epi& E, const int tid) {
    const int wid = __builtin_amdgcn_readfirstlane(tid >> 6), lane = tid & 63, wr = wid >> 2, wc = wid & 3, fr = lane & 15, fq = lane >> 4;
    const int K = g.K, nt = K / BK;
    unsigned voffA[2], voffB[2];
#pragma unroll
    for (int i = 0; i < 2; ++i) { int R, C; stage_rc(tid * 16 + i * 8192, R, C); const int Rb = Epi::PERM ? ((R & ~31) + perm32(R & 31)) : R;
        voffA[i] = (unsigned)(R * K + C) * 2u; voffB[i] = (unsigned)(Rb * K + C) * 2u; }
    const size_t kstep = (size_t)(BK * 2);
    const size_t hstep = (size_t)HALF * K * 2;
    const size_t tstep = 2 * hstep;
    const unsigned ldsw = (unsigned)wid * 1024u;
    const int aoff = lds_byte(wr * 64 + fr, fq * 8), boff = lds_byte(wc * 32 + fr, fq * 8);
#define PG8_SA(b, h) (((b) * 2 + (h)) * HTB)
#define PG8_SB(b, h) ((4 + (b) * 2 + (h)) * HTB)
#define PG8_STAGE(bufoff, gbase, voff) do { _Pragma("unroll") for (int _i = 0; _i < 2; ++_i) \
        __builtin_amdgcn_global_load_lds((const unsigned*)((const char*)(gbase) + (voff)[_i]), (PG8_LAS unsigned*)(lds + (bufoff) + ldsw + _i * 8192), 16, 0, 0); } while (0)
#define PG8_LDA(dst, b, h) do { _Pragma("unroll") for (int m = 0; m < 4; ++m) _Pragma("unroll") for (int k = 0; k < 2; ++k) dst[m][k] = *(const PG8_LAS bf16x8*)(lds + PG8_SA(b, h) + aoff + m * 2048 + k * 1024); } while (0)
#define PG8_LDB(dst, b, h) do { _Pragma("unroll") for (int n = 0; n < 2; ++n) _Pragma("unroll") for (int k = 0; k < 2; ++k) dst[n][k] = *(const PG8_LAS bf16x8*)(lds + PG8_SB(b, h) + boff + n * 2048 + k * 1024); } while (0)
#define PG8_MMA(ai, bj, At, Bt) do { __builtin_amdgcn_s_setprio(1); _Pragma("unroll") for (int m = 0; m < 4; ++m) _Pragma("unroll") for (int n = 0; n < 2; ++n) _Pragma("unroll") for (int k = 0; k < 2; ++k) \
        acc[ai][bj][m][n] = __builtin_amdgcn_mfma_f32_16x16x32_bf16(Bt[n][k], At[m][k], acc[ai][bj][m][n], 0, 0, 0); __builtin_amdgcn_s_setprio(0); } while (0)
#define PG8_WAIT_V(n) asm volatile("s_waitcnt vmcnt(" #n ")" ::: "memory")
#define PG8_WAIT_L(n) asm volatile("s_waitcnt lgkmcnt(" #n ")" ::: "memory")
#define PG8_BAR __builtin_amdgcn_s_barrier()
#define PG8_SCHED __builtin_amdgcn_sched_barrier(0)
    Unit cur, nxt; int ui = 0;
    if (!S.next(0, cur)) return;
    f32x4 acc[2][2][4][2];
#pragma unroll
    for (int a = 0; a < 2; ++a)
#pragma unroll
        for (int b = 0; b < 2; ++b)
#pragma unroll
            for (int m = 0; m < 4; ++m)
#pragma unroll
                for (int n = 0; n < 2; ++n) acc[a][b][m][n] = (f32x4){0.f, 0.f, 0.f, 0.f};
    bf16x8 At[4][2], B0[2][2], B1[2][2];
    const char* cA = (const char*)g.A + (size_t)cur.pm * tstep; const char* cB = (const char*)g.Bt + (size_t)cur.pb * tstep;
    S.a_ready(cur);
    if constexpr (SP2) {
        PG8_STAGE(PG8_SB(0, 0), cB, voffB); PG8_STAGE(PG8_SB(0, 1), cB + hstep, voffB); PG8_STAGE(PG8_SA(0, 0), cA, voffA); PG8_STAGE(PG8_SA(0, 1), cA + hstep, voffA);
        if (wr == 1) PG8_BAR;
        PG8_WAIT_V(2); PG8_BAR;
        PG8_STAGE(PG8_SB(1, 0), cB + kstep, voffB); PG8_STAGE(PG8_SA(1, 0), cA + kstep, voffA); PG8_STAGE(PG8_SB(1, 1), cB + hstep + kstep, voffB);
        PG8_WAIT_V(6); PG8_BAR;
    } else {
        PG8_STAGE(PG8_SB(0, 0), cB, voffB); PG8_STAGE(PG8_SA(0, 0), cA, voffA); PG8_STAGE(PG8_SB(0, 1), cB + hstep, voffB); PG8_STAGE(PG8_SA(0, 1), cA + hstep, voffA);
        if (wr == 1) PG8_BAR;
        PG8_WAIT_V(4); PG8_BAR;
        PG8_STAGE(PG8_SB(1, 0), cB + kstep, voffB); PG8_STAGE(PG8_SA(1, 0), cA + kstep, voffA); PG8_STAGE(PG8_SB(1, 1), cB + hstep + kstep, voffB);
        PG8_WAIT_V(6); PG8_BAR;
    }
    for (;;) {
        const bool has_next = S.next(ui + 1, nxt);
        const char* nA = has_next ? (const char*)g.A + (size_t)nxt.pm * tstep : cA; const char* nB = has_next ? (const char*)g.Bt + (size_t)nxt.pb * tstep : cB;
        for (int t = 0; t < nt; t += 2) {
            const bool last = (t == nt - 2);
            const char* a1 = cA + (size_t)(t + 1) * kstep;
            const char* a2 = last ? nA : cA + (size_t)(t + 2) * kstep; const char* b2 = last ? nB : cB + (size_t)(t + 2) * kstep;
            const char* a3 = a2 + kstep; const char* b3 = b2 + kstep;
            if (last && has_next) S.a_ready(nxt);
            if constexpr (SP2) {
            PG8_LDB(B0, 0, 0); PG8_LDB(B1, 0, 1); PG8_SCHED; PG8_LDA(At, 0, 0); PG8_STAGE(PG8_SA(1, 1), a1 + hstep, voffA);
            PG8_WAIT_V(8); PG8_WAIT_L(0); PG8_BAR; PG8_MMA(0, 0, At, B0); PG8_MMA(0, 1, At, B1); PG8_BAR; PG8_SCHED;
            PG8_LDA(At, 0, 1); PG8_STAGE(PG8_SB(0, 0), b2, voffB); PG8_STAGE(PG8_SB(0, 1), b2 + hstep, voffB); PG8_STAGE(PG8_SA(0, 0), a2, voffA);
            PG8_WAIT_V(8); PG8_WAIT_L(0); PG8_BAR; PG8_MMA(1, 0, At, B0); PG8_MMA(1, 1, At, B1); PG8_BAR; PG8_SCHED;
            PG8_LDB(B0, 1, 0); PG8_LDB(B1, 1, 1); PG8_SCHED; PG8_LDA(At, 1, 0); PG8_STAGE(PG8_SA(0, 1), a2 + hstep, voffA);
            PG8_WAIT_V(8); PG8_WAIT_L(0); PG8_BAR; PG8_MMA(0, 0, At, B0); PG8_MMA(0, 1, At, B1); PG8_BAR; PG8_SCHED;
            PG8_LDA(At, 1, 1); PG8_STAGE(PG8_SB(1, 0), b3, voffB); PG8_STAGE(PG8_SB(1, 1), b3 + hstep, voffB); PG8_STAGE(PG8_SA(1, 0), a3, voffA);
            PG8_WAIT_V(8); PG8_WAIT_L(0); PG8_BAR; PG8_MMA(1, 0, At, B0); PG8_MMA(1, 1, At, B1); PG8_BAR; PG8_SCHED;
            } else {
            PG8_LDB(B0, 0, 0); PG8_SCHED; PG8_LDA(At, 0, 0); PG8_STAGE(PG8_SA(1, 1), a1 + hstep, voffA);
            PG8_WAIT_L(8); PG8_BAR; PG8_WAIT_L(0); PG8_MMA(0, 0, At, B0); PG8_BAR; PG8_SCHED;
            PG8_LDB(B1, 0, 1); PG8_STAGE(PG8_SB(0, 0), b2, voffB);
            PG8_BAR; PG8_WAIT_L(0); PG8_MMA(0, 1, At, B1); PG8_BAR;
            PG8_LDA(At, 0, 1); PG8_STAGE(PG8_SA(0, 0), a2, voffA);
            PG8_BAR; PG8_WAIT_L(0); PG8_MMA(1, 0, At, B0); PG8_BAR; PG8_SCHED;
            PG8_STAGE(PG8_SB(0, 1), b2 + hstep, voffB);
            PG8_WAIT_V(6); PG8_BAR; PG8_MMA(1, 1, At, B1); PG8_BAR;
            PG8_LDB(B0, 1, 0); PG8_SCHED; PG8_LDA(At, 1, 0); PG8_STAGE(PG8_SA(0, 1), a2 + hstep, voffA);
            PG8_WAIT_L(8); PG8_BAR; PG8_WAIT_L(0); PG8_MMA(0, 0, At, B0); PG8_BAR; PG8_SCHED;
            PG8_LDB(B1, 1, 1); PG8_STAGE(PG8_SB(1, 0), b3, voffB);
            PG8_BAR; PG8_WAIT_L(0); PG8_MMA(0, 1, At, B1); PG8_BAR;
            PG8_LDA(At, 1, 1); PG8_STAGE(PG8_SA(1, 0), a3, voffA);
            PG8_BAR; PG8_WAIT_L(0); PG8_MMA(1, 0, At, B0); PG8_BAR; PG8_SCHED;
            PG8_STAGE(PG8_SB(1, 1), b3 + hstep, voffB);
            PG8_WAIT_V(6); PG8_BAR; PG8_MMA(1, 1, At, B1); PG8_BAR;
            }
        }
        if constexpr (ALIGN_EPI) { if (wr == 0) PG8_BAR; }
        if constexpr (!Epi::AFTER_DRAIN) { E(acc, cur, wr, wc, fr, fq); S.done(cur); }
        if (!has_next) break;
#pragma unroll
        for (int a = 0; a < 2; ++a)
#pragma unroll
            for (int b = 0; b < 2; ++b)
#pragma unroll
                for (int m = 0; m < 4; ++m)
#pragma unroll
                    for (int n = 0; n < 2; ++n) acc[a][b][m][n] = (f32x4){0.f, 0.f, 0.f, 0.f};
        cur = nxt; cA = nA; cB = nB; ++ui;
        if constexpr (ALIGN_EPI) { if (wr == 1) PG8_BAR; }
    }
    PG8_WAIT_V(0);
    if constexpr (!ALIGN_EPI) { if (wr == 0) PG8_BAR; }
    PG8_BAR;
    if constexpr (Epi::AFTER_DRAIN) { E.fused(acc, cur, wr, wc, fr, fq, lds, wid, lane); S.done(cur); }
#undef PG8_SA
#undef PG8_SB
#undef PG8_STAGE
#undef PG8_LDA
#undef PG8_LDB
#undef PG8_MMA
#undef PG8_WAIT_V
#undef PG8_WAIT_L
#undef PG8_BAR
#undef PG8_SCHED
}
}

#ifndef MK_ONE_LAUNCH
#define MK_ONE_LAUNCH 0
#endif
constexpr int NWAVES = 8;
constexpr int BATCH = 2, SEQ = 16384, D = 1024, M = BATCH * SEQ, TB = SEQ;
constexpr int RW = 512, NH = 8, HD = 64, PC = 3072, DFF = 2816, NE = 8, NBLK_MAX = 264, MOE_CH = 64, MOE_NCH = 5;
constexpr float LN_EPS = 1e-5f, GN_EPS = 64e-5f, ALPHA = 1.41421356237f;
constexpr size_t MiB = 1u << 20;
constexpr size_t WS_CTL = 0, CTL_ZERO_BYTES = 1 * MiB;
constexpr size_t WS_WIN = 1 * MiB, WS_WOUT = 25 * MiB, WS_WOA = 29 * MiB, WS_WOB = 31 * MiB, WS_WOC = 32 * MiB, WS_WLORA = 33 * MiB, WS_WGU = 35 * MiB, WS_WD = 46 * MiB;
constexpr size_t WS_XB = 52 * MiB, WS_ACT = 116 * MiB;
constexpr size_t WS_P = WS_ACT, WS_G = 212 * MiB, WS_LA = 308 * MiB, WS_LD = 316 * MiB, WS_AA = 348 * MiB, WS_GG = 364 * MiB, WS_O = 380 * MiB, WS_OA = 412 * MiB, WS_UB = 428 * MiB, WS_UC = 436 * MiB;
constexpr size_t WS_MRG = WS_ACT, WS_MRGB = 180 * MiB;
constexpr size_t WS_H = WS_ACT;
constexpr size_t WS_MOEWGU = WS_ACT, WS_MOEWD = 204 * MiB, WS_XG = 248 * MiB, WS_HCH = 380 * MiB, WS_TOKE = 470 * MiB, WS_TOKW = 471 * MiB, WS_SLOT = 472 * MiB, WS_BLKE = 473 * MiB;
constexpr size_t WS_END = 490 * MiB;
constexpr int CW_TMO = 0, CW_BAR = 4096, CW_MOE = 16384;
constexpr int RING_BYTES = 131072, MISC_OFF = RING_BYTES + 320, LDS_BYTES = 147456;

#define GAS __attribute__((address_space(1)))
#define LAS __attribute__((address_space(3)))
typedef unsigned short bf16;
typedef unsigned v4u __attribute__((ext_vector_type(4)));
typedef unsigned v2u __attribute__((ext_vector_type(2)));
typedef float f32x4 __attribute__((ext_vector_type(4)));
typedef float f32x2 __attribute__((ext_vector_type(2)));
#define RLX_AGENT __ATOMIC_RELAXED, __HIP_MEMORY_SCOPE_AGENT
#define LDS_WAIT() asm volatile("s_waitcnt lgkmcnt(0)" ::: "memory")
using pg8::bflo; using pg8::bfhi; using pg8::sigm; using pg8::cvt_pk_bf16;

#define XB_TMO      128
#define XB_XCNT(j)  (256  + 64 * (j))
#define XB_XSUB(j)  (1280 + 64 * (j))
#define XB_XGEN(j)  (2304 + 64 * (j))
#define XB_TOP      3328
#define XB_TOPGEN   3392
#define XCD_BAR_WORDS 3456
#define XB_SPIN_CAP (1u << 18)
__device__ __forceinline__ unsigned xb_ld(unsigned* p)              { return __hip_atomic_load(p, __ATOMIC_RELAXED, __HIP_MEMORY_SCOPE_AGENT); }
__device__ __forceinline__ unsigned xb_add(unsigned* p, unsigned v) { return __hip_atomic_fetch_add(p, v, __ATOMIC_RELAXED, __HIP_MEMORY_SCOPE_AGENT); }
__device__ __forceinline__ unsigned xb_xcc_id() { return (unsigned)__builtin_amdgcn_s_getreg((3 << 11) | 20) & 0xFu; }
#define XB_SPIN(cond, bar) do { unsigned _sp = 0; while (cond) { __builtin_amdgcn_s_sleep(1); \
    if ((++_sp & 255u) == 0u) { if (xb_ld(&(bar)[XB_TMO])) break; if (_sp > XB_SPIN_CAP) { atomicAdd(&(bar)[XB_TMO], 1u); break; } } } } while (0)
struct XcdBarrier { unsigned* bar; unsigned x; volatile LAS unsigned* st; };
__device__ __forceinline__ XcdBarrier xcd_barrier_post(unsigned* bar, volatile LAS unsigned* st, bool leader) {
    XcdBarrier b; b.bar = bar; b.x = xb_xcc_id(); b.st = st;
    if (leader) (void)xb_add(&bar[XB_XCNT(b.x)], 1u);
    return b;
}
__device__ __forceinline__ void xcd_barrier_complete(unsigned* bar, unsigned x, unsigned& nloc, unsigned& nx) {
    const unsigned G = gridDim.x * gridDim.y * gridDim.z;
    unsigned sum, cnt, mine, sp = 0u;
    for (;;) {
        sum = 0u; cnt = 0u; mine = 0u;
#pragma unroll
        for (unsigned j = 0; j < 16; ++j) { const unsigned c = xb_ld(&bar[XB_XCNT(j)]); sum += c; cnt += (c > 0u) ? 1u : 0u; mine = (j == x) ? c : mine; }
        if (sum == G) break;
        __builtin_amdgcn_s_sleep(1);
        if ((++sp & 255u) == 0u) { if (xb_ld(&bar[XB_TMO])) break; if (sp > XB_SPIN_CAP) { atomicAdd(&bar[XB_TMO], 1u); break; } }
    }
    nloc = mine > 0u ? mine : 1u; nx = cnt > 0u ? cnt : 1u;
}
__device__ __forceinline__ void xcd_barrier(const XcdBarrier& b, bool leader) {
    asm volatile("s_waitcnt vmcnt(0)" ::: "memory");
    __syncthreads();
    if (leader) {
        unsigned* bar = b.bar;
        __builtin_amdgcn_s_waitcnt(0);
        unsigned nloc = b.st[0], nx = b.st[1];
        if (nloc == 0u) { xcd_barrier_complete(bar, b.x, nloc, nx); b.st[0] = nloc; b.st[1] = nx; }
        const unsigned old = xb_add(&bar[XB_XSUB(b.x)], 1u);
        const unsigned gen = old / nloc;
        if (old + 1u == (gen + 1u) * nloc) {
            __builtin_amdgcn_fence(__ATOMIC_RELEASE, "agent");
            asm volatile("s_waitcnt vmcnt(0)" ::: "memory");
            const unsigned og = xb_add(&bar[XB_TOP], 1u);
            const unsigned tg = og / nx;
            if (og + 1u == (tg + 1u) * nx) xb_add(&bar[XB_TOPGEN], 1u);
            else XB_SPIN(xb_ld(&bar[XB_TOPGEN]) == tg, bar);
            __builtin_amdgcn_fence(__ATOMIC_ACQUIRE, "agent");
            xb_add(&bar[XB_XGEN(b.x)], 1u);
            asm volatile("s_waitcnt vmcnt(0)" ::: "memory");
        } else {
            XB_SPIN(xb_ld(&bar[XB_XGEN(b.x)]) == gen, bar);
            __builtin_amdgcn_fence(__ATOMIC_ACQUIRE, "agent");
            asm volatile("s_waitcnt vmcnt(0)" ::: "memory");
        }
    }
    __syncthreads();
}

__device__ __forceinline__ float wave_sum(float v) {
#pragma unroll
    for (int o = 1; o < 64; o <<= 1) v += __shfl_xor(v, o);
    return v;
}
__device__ __forceinline__ float red8(float v) { v += __shfl_xor(v, 1); v += __shfl_xor(v, 2); v += __shfl_xor(v, 4); return v; }
__device__ __forceinline__ void ld8bf(const bf16* p, float (&o)[8]) { const v4u w = *(const v4u*)p; o[0] = bflo(w.x); o[1] = bfhi(w.x); o[2] = bflo(w.y); o[3] = bfhi(w.y); o[4] = bflo(w.z); o[5] = bfhi(w.z); o[6] = bflo(w.w); o[7] = bfhi(w.w); }
__device__ __forceinline__ void ld4bf(const bf16* p, float (&o)[4]) { const v2u w = *(const v2u*)p; o[0] = bflo(w.x); o[1] = bfhi(w.x); o[2] = bflo(w.y); o[3] = bfhi(w.y); }
__device__ __forceinline__ void ld8f(const float* p, float (&o)[8]) { const f32x4 a = *(const f32x4*)p, b = *(const f32x4*)(p + 4); o[0] = a[0]; o[1] = a[1]; o[2] = a[2]; o[3] = a[3]; o[4] = b[0]; o[5] = b[1]; o[6] = b[2]; o[7] = b[3]; }
__device__ __forceinline__ void ld4f(const float* p, float (&o)[4]) { const f32x4 a = *(const f32x4*)p; o[0] = a[0]; o[1] = a[1]; o[2] = a[2]; o[3] = a[3]; }
__device__ __forceinline__ void st8bf(bf16* p, const float (&v)[8]) { v4u w; w.x = cvt_pk_bf16(v[0], v[1]); w.y = cvt_pk_bf16(v[2], v[3]); w.z = cvt_pk_bf16(v[4], v[5]); w.w = cvt_pk_bf16(v[6], v[7]); *(v4u*)p = w; }
__device__ __forceinline__ void st4bf(bf16* p, const float (&v)[4]) { v2u w; w.x = cvt_pk_bf16(v[0], v[1]); w.y = cvt_pk_bf16(v[2], v[3]); *(v2u*)p = w; }
__device__ __forceinline__ void shift8(const bf16* Prow, bool hasprev, int col, const float* mu, float (&o)[8]) {
    float c[8], p[8], m[8]; ld8bf(Prow + col, c); ld8f(mu + col, m);
    if (hasprev) ld8bf(Prow - PC + col, p); else {
#pragma unroll
        for (int j = 0; j < 8; ++j) p[j] = 0.f; }
#pragma unroll
    for (int j = 0; j < 8; ++j) o[j] = c[j] + (p[j] - c[j]) * m[j];
}
__device__ __forceinline__ void shift4(const bf16* Prow, bool hasprev, int col, const float* mu, float (&o)[4]) {
    float c[4], p[4], m[4]; ld4bf(Prow + col, c); ld4f(mu + col, m);
    if (hasprev) ld4bf(Prow - PC + col, p); else {
#pragma unroll
        for (int j = 0; j < 4; ++j) p[j] = 0.f; }
#pragma unroll
    for (int j = 0; j < 4; ++j) o[j] = c[j] + (p[j] - c[j]) * m[j];
}

struct Frame {
    LAS unsigned char* lds;
    unsigned* ctl;
    int tid, lane, wave, vcu, G, gw, NGW;
    int z;
    float* out; unsigned char* ws;
    __device__ __forceinline__ const float* in(int k) const { typedef const float* const __attribute__((address_space(4))) * KP; KP kin = (KP)__builtin_amdgcn_kernarg_segment_ptr(); return (const float*)(const GAS float*)kin[k + z]; }
};
__device__ __forceinline__ int lane_id() { int l; asm volatile("v_mbcnt_lo_u32_b32 %0, -1, 0\n\tv_mbcnt_hi_u32_b32 %0, -1, %0" : "=v"(l)); return l; }
__device__ __forceinline__ void mkframe(Frame& F, LAS unsigned char* lds, unsigned char* ws, float* out, int wave_s) {
    int tid = wave_s * 64 + lane_id(); asm volatile("" : "+v"(tid));
    int z = 0; asm volatile("" : "+s"(z));
    F.lds = lds; F.z = z; F.tid = tid; F.lane = tid & 63; F.wave = wave_s;
    F.G = (int)gridDim.x + z; { const int bx = (int)blockIdx.x + z; F.vcu = (F.G % 8 == 0) ? (bx % 8) * (F.G / 8) + bx / 8 : bx; }
    F.gw = F.vcu * NWAVES + F.wave; F.NGW = F.G * NWAVES;
    F.ws = ws + z; F.out = out + z; F.ctl = (unsigned*)(F.ws + WS_CTL);
}
template <class T> __device__ __forceinline__ T* wsp(const Frame& F, size_t off) { return (T*)(F.ws + off); }

template <int MODE>
__device__ __forceinline__ void transpose_item(const float* W, int K, int N, bf16* WT, int row_off, LAS float* scr, int item, int lane) {
    const int nblk = N / 32, kb = item / nblk, nb = item % nblk, k0 = 64 * kb, n0 = 32 * nb;
#pragma unroll 8
    for (int i = 0; i < 32; ++i) { const int kk = 2 * i + (lane >> 5); scr[kk * 33 + (lane & 31)] = W[(size_t)(k0 + kk) * N + n0 + (lane & 31)]; }
    LDS_WAIT(); asm volatile("" ::: "memory");
    const int c = lane & 7;
    const int drow0 = MODE == 0 ? row_off + n0 : (n0 / 128) * 256 + (n0 % 128) + row_off;
#pragma unroll
    for (int j = 0; j < 4; ++j) { const int n = (lane >> 3) + 8 * j; const LAS float* s = scr + (8 * c) * 33 + n;
        v4u o; o.x = cvt_pk_bf16(s[0 * 33], s[1 * 33]); o.y = cvt_pk_bf16(s[2 * 33], s[3 * 33]); o.z = cvt_pk_bf16(s[4 * 33], s[5 * 33]); o.w = cvt_pk_bf16(s[6 * 33], s[7 * 33]);
        *(v4u*)(WT + (size_t)(drow0 + n) * K + k0 + 8 * c) = o; }
    LDS_WAIT(); asm volatile("" ::: "memory");
}
template <int MODE>
__device__ __forceinline__ void transpose_all(const Frame& F, const float* W, int K, int N, bf16* WT, int row_off) {
    LAS float* scr = (LAS float*)(F.lds + F.wave * 16384);
    const int nitems = (K / 64) * (N / 32);
    for (int it = F.gw; it < nitems; it += F.NGW) transpose_item<MODE>(W, K, N, WT, row_off, scr, it, F.lane);
}

__device__ __forceinline__ void p0_prologue(const Frame& F) {
    for (int l = 0; l < 2; ++l) {
        transpose_all<0>(F, F.in(1) + (size_t)l * D * 6144, D, 6144, wsp<bf16>(F, WS_WIN) + (size_t)l * 6144 * D, 0);
        transpose_all<0>(F, F.in(13) + (size_t)l * RW * D, RW, D, wsp<bf16>(F, WS_WOA) + (size_t)l * D * RW, 0);
        transpose_all<0>(F, F.in(18) + (size_t)l * 256 * D, 256, D, wsp<bf16>(F, WS_WOB) + (size_t)l * D * 256, 0);
        transpose_all<0>(F, F.in(20) + (size_t)l * 256 * D, 256, D, wsp<bf16>(F, WS_WOC) + (size_t)l * D * 256, 0);
        transpose_all<0>(F, F.in(21) + (size_t)l * D * D, D, D, wsp<bf16>(F, WS_WOUT) + (size_t)l * D * D, 0);
        bf16* WL = wsp<bf16>(F, WS_WLORA) + (size_t)l * (MiB / 2);
        const float* w2 = F.in(4) + (size_t)l * 64 * RW; const float* a2 = F.in(6) + (size_t)l * 64 * RW; const float* g2 = F.in(7) + (size_t)l * 128 * RW;
        for (int idx = F.gw * 64 + F.lane; idx < 1536 * 256; idx += F.NGW * 64) {
            const int n = idx >> 8, k = idx & 255; float v = 0.f;
            if (n < 512) { if (k < 64) v = w2[k * RW + n]; }
            else if (n < 1024) { if (k >= 64 && k < 128) v = a2[(k - 64) * RW + (n - 512)]; }
            else { if (k >= 128) v = g2[(k - 128) * RW + (n - 1024)]; }
            WL[idx] = (bf16)(cvt_pk_bf16(v, 0.f) & 0xffffu);
        }
    }
    transpose_all<1>(F, F.in(24), D, DFF, wsp<bf16>(F, WS_WGU), 0);
    transpose_all<1>(F, F.in(25), D, DFF, wsp<bf16>(F, WS_WGU), 128);
    transpose_all<0>(F, F.in(26), DFF, D, wsp<bf16>(F, WS_WD), 0);
    const float* x = F.in(0); bf16* xb = wsp<bf16>(F, WS_XB);
    for (size_t i = ((size_t)F.gw * 64 + F.lane) * 8; i < (size_t)M * D; i += (size_t)F.NGW * 64 * 8) { float v[8]; ld8f(x + i, v); st8bf(xb + i, v); }
}
__device__ __forceinline__ void moe_weights(const Frame& F) {
    for (int e = 0; e < NE; ++e) {
        transpose_all<1>(F, F.in(28) + (size_t)e * D * DFF, D, DFF, wsp<bf16>(F, WS_MOEWGU) + (size_t)e * 2 * DFF * D, 0);
        transpose_all<1>(F, F.in(29) + (size_t)e * D * DFF, D, DFF, wsp<bf16>(F, WS_MOEWGU) + (size_t)e * 2 * DFF * D, 128);
        transpose_all<0>(F, F.in(30) + (size_t)e * DFF * D, DFF, D, wsp<bf16>(F, WS_MOEWD) + (size_t)e * D * DFF, 0);
    }
}

__device__ __forceinline__ void phase_b(const Frame& F, int l) {
    const bf16* P = wsp<bf16>(F, WS_P);
    {
        LAS float* U = (LAS float*)F.lds; LAS float* DW = (LAS float*)(F.lds + 94 * 1024);
        const float* dw = F.in(14) + (size_t)l * 31 * 256; const float* dwb = F.in(15) + l * 256; const float* lg = F.in(16) + l * 256; const float* lb = F.in(17) + l * 256;
        bf16* UB = wsp<bf16>(F, WS_UB);
        for (int u = F.vcu; u < TB / 64; u += F.G) {
            const int t0 = u * 64;
            for (int idx = F.tid; idx < 94 * 32; idx += 512) { const int row = idx >> 5, g8 = idx & 31, t = t0 - 30 + row; float o[8];
                if (t >= 0) { float a[8], g[8]; ld8bf(P + (size_t)t * PC + 1792 + 8 * g8, a); ld8bf(P + (size_t)t * PC + 2048 + 8 * g8, g);
#pragma unroll
                    for (int j = 0; j < 8; ++j) o[j] = a[j] * sigm(g[j]); }
                else {
#pragma unroll
                    for (int j = 0; j < 8; ++j) o[j] = 0.f; }
                *(LAS f32x4*)(U + row * 256 + 8 * g8) = (f32x4){o[0], o[1], o[2], o[3]}; *(LAS f32x4*)(U + row * 256 + 8 * g8 + 4) = (f32x4){o[4], o[5], o[6], o[7]}; }
            for (int idx = F.tid; idx < 31 * 64; idx += 512) *(LAS f32x4*)(DW + 4 * idx) = *(const f32x4*)(dw + 4 * idx);
            __syncthreads();
            const int c = 4 * F.lane; const f32x4 bias = *(const f32x4*)(dwb + c), gg = *(const f32x4*)(lg + c), bb = *(const f32x4*)(lb + c);
            for (int i = 0; i < 8; ++i) { const int tt = F.wave * 8 + i; f32x4 acc = bias;
#pragma unroll
                for (int j = 0; j < 31; ++j) acc += *(const LAS f32x4*)(DW + j * 256 + c) * *(const LAS f32x4*)(U + (tt + j) * 256 + c);
                const float mean = wave_sum((acc[0] + acc[1]) + (acc[2] + acc[3])) * (1.f / 256.f); const f32x4 d = acc - mean;
                const float var = wave_sum((d[0] * d[0] + d[1] * d[1]) + (d[2] * d[2] + d[3] * d[3])) * (1.f / 256.f); const float rstd = 1.f / sqrtf(var + LN_EPS);
                float y[4];
#pragma unroll
                for (int j = 0; j < 4; ++j) { const float z = d[j] * rstd * gg[j] + bb[j]; y[j] = z * sigm(z); }
                st4bf(UB + (size_t)(t0 + tt) * 256 + c, y); }
            __syncthreads();
        }
    }
    {
        bf16* LA = wsp<bf16>(F, WS_LA); const float* mu = F.in(2) + (size_t)l * 1792;
        for (int tp = F.gw; tp < TB / 2; tp += F.NGW) { const int t = 2 * tp + (F.lane >> 5), j8 = F.lane & 31; float v[8];
            shift8(P + (size_t)t * PC, t > 0, 1536 + 8 * j8, mu, v);
            if (j8 < 8) {
#pragma unroll
                for (int j = 0; j < 8; ++j) v[j] = 1.f - 2.f * __builtin_amdgcn_rcpf(1.f + __expf(2.f * v[j])); }
            else if (j8 >= 16) {
#pragma unroll
                for (int j = 0; j < 8; ++j) v[j] = sigm(v[j]); }
            st8bf(LA + (size_t)t * 256 + 8 * j8, v); }
    }
    {
        bf16* UC = wsp<bf16>(F, WS_UC); const float* dw = F.in(19) + (size_t)l * 3 * 256;
        const int c = 4 * F.lane; f32x4 w[3];
#pragma unroll
        for (int d = 0; d < 3; ++d) w[d] = *(const f32x4*)(dw + d * 256 + c);
        for (int t = F.gw; t < TB; t += F.NGW) { float gb[4]; ld4bf(P + (size_t)t * PC + 2304 + c, gb); float acc[4] = {0.f, 0.f, 0.f, 0.f};
#pragma unroll
            for (int d = 0; d < 3; ++d) { const int tt = t - 2 + d; if (tt >= 0) { float gc[4], h[4]; ld4bf(P + (size_t)tt * PC + 2560 + c, gc); ld4bf(P + (size_t)tt * PC + 2816 + c, h);
#pragma unroll
                    for (int j = 0; j < 4; ++j) acc[j] += w[d][j] * gc[j] * h[j]; } }
#pragma unroll
            for (int j = 0; j < 4; ++j) acc[j] *= gb[j];
            st4bf(UC + (size_t)t * 256 + c, acc); }
    }
}

__device__ __forceinline__ void phase_scan_naive(const Frame& F, int l) {
    const int h = (int)blockIdx.x + F.z;
    if (h >= NH) return;
    const bf16* P = wsp<bf16>(F, WS_P); const bf16* AA = wsp<bf16>(F, WS_AA); const float* LD = wsp<float>(F, WS_LD); float* O = wsp<float>(F, WS_O);
    const float* mu = F.in(2) + (size_t)l * 1792; const float* k_k = F.in(8) + l * RW; const float* k_a = F.in(9) + l * RW;
    LAS float* L = (LAS float*)F.lds;
    const int tt = F.tid >> 4, cg = F.tid & 15, c = 4 * cg, col = h * HD + c;
    float kk4[4], ka4[4]; ld4f(k_k + col, kk4); ld4f(k_a + col, ka4);
    float r4[4], k4[4], v4[4], a4[4], ld4[4];
    auto load_block = [&](int blk) { const int t = blk * 32 + tt; const bf16* pr = P + (size_t)t * PC;
        shift4(pr, t > 0, col, mu, r4); shift4(pr, t > 0, 512 + col, mu, k4); shift4(pr, t > 0, 1024 + col, mu, v4);
        ld4bf(AA + (size_t)t * RW + col, a4); ld4f(LD + (size_t)t * RW + col, ld4); };
    auto write_block = [&](int buf) { LAS float* B = L + buf * (6 * 32 * 64) + tt * 64 + c;
        float kx[4], ss = 0.f;
#pragma unroll
        for (int j = 0; j < 4; ++j) { kx[j] = k4[j] * kk4[j]; ss += kx[j] * kx[j]; }
        ss += __shfl_xor(ss, 1); ss += __shfl_xor(ss, 2); ss += __shfl_xor(ss, 4); ss += __shfl_xor(ss, 8);
        const float inv = 1.f / fmaxf(sqrtf(ss), 1e-12f);
        f32x4 dec, kap, kb, kp;
#pragma unroll
        for (int j = 0; j < 4; ++j) { dec[j] = __expf(ld4[j]); kap[j] = kx[j] * inv; kb[j] = kap[j] * a4[j]; kp[j] = k4[j] * (1.f + (a4[j] - 1.f) * ka4[j]); }
        *(LAS f32x4*)(B + 0 * 2048) = dec; *(LAS f32x4*)(B + 1 * 2048) = kap; *(LAS f32x4*)(B + 2 * 2048) = kb; *(LAS f32x4*)(B + 3 * 2048) = kp;
        *(LAS f32x4*)(B + 4 * 2048) = (f32x4){r4[0], r4[1], r4[2], r4[3]}; *(LAS f32x4*)(B + 5 * 2048) = (f32x4){v4[0], v4[1], v4[2], v4[3]}; };
    const int vl = F.lane >> 3, kq = F.lane & 7, vrow = F.wave * 8 + vl, k0 = 8 * kq;
    float s[8];
#pragma unroll
    for (int j = 0; j < 8; ++j) s[j] = 0.f;
    load_block(0); write_block(0); __syncthreads();
    for (int blk = 0; blk < TB / 32; ++blk) {
        const int buf = blk & 1;
        if (blk + 1 < TB / 32) load_block(blk + 1);
        const LAS float* B = L + buf * (6 * 32 * 64);
        for (int i = 0; i < 32; ++i) {
            const LAS float* Bi = B + i * 64 + k0;
            float dec[8], kap[8], kb[8], kp[8], rr[8];
#pragma unroll
            for (int q = 0; q < 2; ++q) { const f32x4 a = *(const LAS f32x4*)(Bi + 0 * 2048 + 4 * q), b = *(const LAS f32x4*)(Bi + 1 * 2048 + 4 * q), cc = *(const LAS f32x4*)(Bi + 2 * 2048 + 4 * q), d = *(const LAS f32x4*)(Bi + 3 * 2048 + 4 * q), e = *(const LAS f32x4*)(Bi + 4 * 2048 + 4 * q);
#pragma unroll
                for (int j = 0; j < 4; ++j) { dec[4 * q + j] = a[j]; kap[4 * q + j] = b[j]; kb[4 * q + j] = cc[j]; kp[4 * q + j] = d[j]; rr[4 * q + j] = e[j]; } }
            const float vv = B[5 * 2048 + i * 64 + vrow];
            float sa = 0.f;
#pragma unroll
            for (int j = 0; j < 8; ++j) sa -= s[j] * kap[j];
            sa = red8(sa);
            float o = 0.f;
#pragma unroll
            for (int j = 0; j < 8; ++j) { s[j] = s[j] * dec[j] + sa * kb[j] + vv * kp[j]; o += s[j] * rr[j]; }
            o = red8(o);
            if (kq == 0) O[(size_t)(blk * 32 + i) * RW + h * HD + vrow] = o;
        }
        if (blk + 1 < TB / 32) write_block(buf ^ 1);
        __syncthreads();
    }
}

__device__ __forceinline__ void phase_post(const Frame& F, int l) {
    const bf16* P = wsp<bf16>(F, WS_P); const bf16* AA = wsp<bf16>(F, WS_AA); const bf16* GG = wsp<bf16>(F, WS_GG); const float* O = wsp<float>(F, WS_O); bf16* OA = wsp<bf16>(F, WS_OA);
    const float* mu = F.in(2) + (size_t)l * 1792;
    const int c = 8 * F.lane; float ka[8], rk[8], lg[8], lb[8];
    ld8f(F.in(9) + l * RW + c, ka); ld8f(F.in(10) + l * RW + c, rk); ld8f(F.in(11) + l * RW + c, lg); ld8f(F.in(12) + l * RW + c, lb);
    for (int t = F.gw; t < TB; t += F.NGW) {
        float o[8], r[8], k[8], v[8], a[8], g[8]; const bf16* pr = P + (size_t)t * PC;
        ld8f(O + (size_t)t * RW + c, o); shift8(pr, t > 0, c, mu, r); shift8(pr, t > 0, 512 + c, mu, k); shift8(pr, t > 0, 1024 + c, mu, v);
        ld8bf(AA + (size_t)t * RW + c, a); ld8bf(GG + (size_t)t * RW + c, g);
        float s = 0.f;
#pragma unroll
        for (int j = 0; j < 8; ++j) s += o[j];
        const float mean = red8(s) * (1.f / 64.f); float q = 0.f, bon = 0.f;
#pragma unroll
        for (int j = 0; j < 8; ++j) { o[j] -= mean; q += o[j] * o[j]; bon += r[j] * k[j] * (1.f + (a[j] - 1.f) * ka[j]) * rk[j]; }
        const float rstd = 1.f / sqrtf(red8(q) * (1.f / 64.f) + GN_EPS); bon = red8(bon);
        float y[8];
#pragma unroll
        for (int j = 0; j < 8; ++j) y[j] = (o[j] * rstd * lg[j] + lb[j] + bon * v[j]) * g[j];
        st8bf(OA + (size_t)t * RW + c, y);
    }
}

__device__ __forceinline__ void ln_row(float* xrow, bf16* brow, const float* g, const float* b, int lane) {
    f32x4 v[4]; float s = 0.f;
#pragma unroll
    for (int j = 0; j < 4; ++j) { v[j] = *(const f32x4*)(xrow + 4 * lane + 256 * j); s += (v[j][0] + v[j][1]) + (v[j][2] + v[j][3]); }
    const float mean = wave_sum(s) * (1.f / D); float s2 = 0.f;
#pragma unroll
    for (int j = 0; j < 4; ++j) { v[j] = v[j] - mean; s2 += (v[j][0] * v[j][0] + v[j][1] * v[j][1]) + (v[j][2] * v[j][2] + v[j][3] * v[j][3]); }
    const float rstd = 1.f / sqrtf(wave_sum(s2) * (1.f / D) + LN_EPS);
#pragma unroll
    for (int j = 0; j < 4; ++j) { const f32x4 gg = *(const f32x4*)(g + 4 * lane + 256 * j), bb = *(const f32x4*)(b + 4 * lane + 256 * j); const f32x4 y = v[j] * rstd * gg + bb;
        *(f32x4*)(xrow + 4 * lane + 256 * j) = y;
        if (brow) { v2u w; w.x = cvt_pk_bf16(y[0], y[1]); w.y = cvt_pk_bf16(y[2], y[3]); *(v2u*)(brow + 4 * lane + 256 * j) = w; } }
}
__device__ __forceinline__ void phase_ln(const Frame& F, int r0, int nrows, const float* g, const float* b) {
    bf16* xb = wsp<bf16>(F, WS_XB);
    for (int m = F.gw; m < nrows; m += F.NGW) ln_row(F.out + (size_t)(r0 + m) * D, xb + (size_t)(r0 + m) * D, g, b, F.lane);
}

__device__ __forceinline__ void phase_router(const Frame& F) {
    LAS float* WR = (LAS float*)F.lds; LAS unsigned* lcnt = (LAS unsigned*)(F.lds + 32768);
    const float* wr = F.in(27);
    for (int i = F.tid; i < D * NE / 4; i += 512) *(LAS f32x4*)(WR + 4 * i) = *(const f32x4*)(wr + 4 * i);
    if (F.tid < NE) lcnt[F.tid] = 0u;
    __syncthreads();
    int* TOKE = wsp<int>(F, WS_TOKE); f32x2* TOKW = wsp<f32x2>(F, WS_TOKW);
    for (int t = F.gw; t < M; t += F.NGW) {
        const float* xr = F.out + (size_t)t * D; float lg[NE];
#pragma unroll
        for (int e = 0; e < NE; ++e) lg[e] = 0.f;
#pragma unroll
        for (int j = 0; j < 4; ++j) { const f32x4 xv = *(const f32x4*)(xr + 4 * F.lane + 256 * j);
#pragma unroll
            for (int q = 0; q < 4; ++q) { const LAS float* w = WR + (4 * F.lane + 256 * j + q) * NE; const f32x4 w0 = *(const LAS f32x4*)w, w1 = *(const LAS f32x4*)(w + 4);
                lg[0] += xv[q] * w0[0]; lg[1] += xv[q] * w0[1]; lg[2] += xv[q] * w0[2]; lg[3] += xv[q] * w0[3]; lg[4] += xv[q] * w1[0]; lg[5] += xv[q] * w1[1]; lg[6] += xv[q] * w1[2]; lg[7] += xv[q] * w1[3]; } }
#pragma unroll
        for (int e = 0; e < NE; ++e) lg[e] = wave_sum(lg[e]);
        int e1 = 0; float l1 = lg[0];
#pragma unroll
        for (int e = 1; e < NE; ++e) if (lg[e] > l1) { l1 = lg[e]; e1 = e; }
        int e2 = -1; float l2 = -3.0e38f;
#pragma unroll
        for (int e = 0; e < NE; ++e) if (e != e1 && lg[e] > l2) { l2 = lg[e]; e2 = e; }
        const float ex = __expf(l2 - l1), w1 = 1.f / (1.f + ex), w2 = ex * w1;
        if (F.lane == 0) { TOKE[t] = e1 | (e2 << 8); TOKW[t] = (f32x2){w1, w2}; atomicAdd((unsigned*)&lcnt[e1], 1u); atomicAdd((unsigned*)&lcnt[e2], 1u); }
    }
    __syncthreads();
    if (F.tid < NE && lcnt[F.tid]) __hip_atomic_fetch_add(F.ctl + CW_MOE + 64 * F.tid, lcnt[F.tid], RLX_AGENT);
}
__device__ __forceinline__ void phase_assign(const Frame& F) {
    LAS unsigned* lc = (LAS unsigned*)F.lds;
    LAS int* lslot = (LAS int*)(F.lds + 256);
    const int* TOKE = wsp<int>(F, WS_TOKE); int* SLOT = wsp<int>(F, WS_SLOT); int* BLKE = wsp<int>(F, WS_BLKE);
    unsigned cnt[NE], pst[NE]; unsigned acc = 0;
#pragma unroll
    for (int e = 0; e < NE; ++e) { cnt[e] = __hip_atomic_load(F.ctl + CW_MOE + 64 * e, RLX_AGENT); pst[e] = acc; acc += ((cnt[e] + 255u) >> 8) << 8; }
    const int nblk = (int)(acc >> 8);
    if (F.tid < NE) lc[F.tid] = 0u;
    if (F.tid == 0) {
#pragma unroll
        for (int e = 0; e < NE; ++e) lc[16 + e] = pst[e]; }
    __syncthreads();
    if ((int)blockIdx.x + F.z == 0) { for (int i = F.tid; i <= NBLK_MAX; i += 512) { int e = 0;
#pragma unroll
            for (int q = 1; q < NE; ++q) if ((unsigned)(i * 256) >= pst[q]) e = q;
            if (i < NBLK_MAX) BLKE[i] = e; else BLKE[NBLK_MAX] = nblk; } }
    const int tpw = M / F.G;
    const int t0 = F.vcu * tpw;
    int e1 = 0, e2 = 0, r1 = 0, r2 = 0;
    for (int base = 0; base < tpw; base += 512) {
        const int i = base + F.tid;
        if (i < tpw) { const int te = TOKE[t0 + i]; e1 = te & 255; e2 = te >> 8; r1 = (int)atomicAdd((unsigned*)&lc[e1], 1u); r2 = (int)atomicAdd((unsigned*)&lc[e2], 1u); }
    }
    __syncthreads();
    if (F.tid < NE) lc[8 + F.tid] = lc[F.tid] ? __hip_atomic_fetch_add(F.ctl + CW_MOE + 64 * (8 + F.tid), lc[F.tid], RLX_AGENT) : 0u;
    __syncthreads();
    if (F.tid < tpw) { const int s1 = (int)(lc[16 + e1] + lc[8 + e1]) + r1, s2 = (int)(lc[16 + e2] + lc[8 + e2]) + r2; lslot[2 * F.tid] = s1; lslot[2 * F.tid + 1] = s2; SLOT[2 * (t0 + F.tid)] = s1; SLOT[2 * (t0 + F.tid) + 1] = s2; }
    __syncthreads();
    const bf16* xb = wsp<bf16>(F, WS_XB); bf16* XG = wsp<bf16>(F, WS_XG);
    for (int i = F.wave; i < tpw; i += NWAVES) { const v4u* src = (const v4u*)(xb + (size_t)(t0 + i) * D); const v4u a = src[F.lane], b = src[64 + F.lane];
#pragma unroll
        for (int q = 0; q < 2; ++q) { v4u* dst = (v4u*)(XG + (size_t)lslot[2 * i + q] * D); dst[F.lane] = a; dst[64 + F.lane] = b; } }
}
__device__ __forceinline__ void phase_combine(const Frame& F, const float* g, const float* b) {
    const bf16* YD = wsp<bf16>(F, WS_XG); const int* SLOT = wsp<int>(F, WS_SLOT); const f32x2* TOKW = wsp<f32x2>(F, WS_TOKW);
    for (int t = F.gw; t < M; t += F.NGW) {
        float* xrow = F.out + (size_t)t * D; const int s1 = SLOT[2 * t], s2 = SLOT[2 * t + 1]; const f32x2 w = TOKW[t];
        const bf16* y1 = YD + (size_t)s1 * D; const bf16* y2 = YD + (size_t)s2 * D;
#pragma unroll
        for (int j = 0; j < 4; ++j) { const int cidx = 4 * F.lane + 256 * j; f32x4 v = *(const f32x4*)(xrow + cidx); float a[4], c[4]; ld4bf(y1 + cidx, a); ld4bf(y2 + cidx, c);
#pragma unroll
            for (int q = 0; q < 4; ++q) v[q] = v[q] * ALPHA + w[0] * a[q] + w[1] * c[q];
            *(f32x4*)(xrow + cidx) = v; }
        ln_row(xrow, nullptr, g, b, F.lane);
    }
}

struct Args { const float* in[33]; float* out; unsigned char* ws; int ph_lo, ph_hi; };
constexpr int NPH = 1 + 2 * 16 + 3 + (2 + 2 * MOE_NCH + 1);
struct KState { LAS unsigned char* L; unsigned char* ws; float* out; int lo, hi, wave_s; XcdBarrier bar; };
#define PH_ON (K.lo <= pid && pid < K.hi)
#define PH_END do { if (K.lo <= pid && pid + 1 < K.hi) xcd_barrier(K.bar, K.wave_s == 0 && lane_id() == 0); ++pid; } while (0)
#define FRAME() Frame F; mkframe(F, K.L, K.ws, K.out, K.wave_s); LAS unsigned char* ring = F.lds; const int cid = (int)blockIdx.x + F.z; (void)ring; (void)cid

template <int l, int b> __device__ __forceinline__ void mixer_phases(const KState& K, int& pid) {
    if (PH_ON) { FRAME(); const size_t r0 = (size_t)b * TB;
        pg8::Gemm g{wsp<bf16>(F, WS_XB) + r0 * D, wsp<bf16>(F, WS_WIN) + (size_t)l * 6144 * D, TB, 6144, D}; pg8::StaticOrder S; S.init(TB, 6144, F.G, cid);
        pg8::EpiPG E{wsp<bf16>(F, WS_P), wsp<bf16>(F, WS_G)}; pg8::gemm_phase<pg8::EpiPG, pg8::StaticOrder, true, true>(ring, g, S, E, F.tid); }
    PH_END;
    if (PH_ON) { FRAME(); phase_b(F, l); }
    PH_END;
    if (PH_ON) { FRAME(); pg8::Gemm g{wsp<bf16>(F, WS_LA), wsp<bf16>(F, WS_WLORA) + (size_t)l * (MiB / 2), TB, 1536, 256}; pg8::StaticOrder S; S.init(TB, 1536, F.G, cid);
        pg8::EpiLora E{wsp<float>(F, WS_LD), wsp<bf16>(F, WS_AA), (long)((WS_GG - WS_AA) / 2), F.in(3) + l * RW, F.in(5) + l * RW}; pg8::gemm_phase<pg8::EpiLora, pg8::StaticOrder, true, true>(ring, g, S, E, F.tid); }
    PH_END;
    if (PH_ON) { FRAME(); phase_scan_naive(F, l); }
    PH_END;
    if (PH_ON) { FRAME(); phase_post(F, l); }
    PH_END;
    if (PH_ON) { FRAME();
        { pg8::Gemm g{wsp<bf16>(F, WS_OA), wsp<bf16>(F, WS_WOA) + (size_t)l * D * RW, TB, D, RW}; pg8::StaticOrder S; S.init(TB, D, F.G, cid);
          pg8::EpiMerge<0> E{wsp<bf16>(F, WS_G), 0, wsp<float>(F, WS_MRG), wsp<bf16>(F, WS_MRGB)}; pg8::gemm_phase<pg8::EpiMerge<0>, pg8::StaticOrder, true, true>(ring, g, S, E, F.tid); } }
    if (PH_ON) { FRAME();
        { pg8::Gemm g{wsp<bf16>(F, WS_UB), wsp<bf16>(F, WS_WOB) + (size_t)l * D * 256, TB, D, 256}; pg8::StaticOrder S; S.init(TB, D, F.G, cid);
          pg8::EpiMerge<1> E{wsp<bf16>(F, WS_G), 1024, wsp<float>(F, WS_MRG), wsp<bf16>(F, WS_MRGB)}; pg8::gemm_phase<pg8::EpiMerge<1>, pg8::StaticOrder, true, true>(ring, g, S, E, F.tid); } }
    if (PH_ON) { FRAME();
        { pg8::Gemm g{wsp<bf16>(F, WS_UC), wsp<bf16>(F, WS_WOC) + (size_t)l * D * 256, TB, D, 256}; pg8::StaticOrder S; S.init(TB, D, F.G, cid);
          pg8::EpiMerge<2> E{wsp<bf16>(F, WS_G), 2048, wsp<float>(F, WS_MRG), wsp<bf16>(F, WS_MRGB)}; pg8::gemm_phase<pg8::EpiMerge<2>, pg8::StaticOrder, true, true>(ring, g, S, E, F.tid); } }
    PH_END;
    if (PH_ON) { FRAME(); const size_t r0 = (size_t)b * TB;
        pg8::Gemm g{wsp<bf16>(F, WS_MRGB), wsp<bf16>(F, WS_WOUT) + (size_t)l * D * D, TB, D, D}; pg8::StaticOrder S; S.init(TB, D, F.G, cid);
        pg8::EpiResid E{(l == 0 ? F.in(0) : (const float*)F.out) + r0 * D, F.out + r0 * D, ALPHA}; pg8::gemm_phase<pg8::EpiResid, pg8::StaticOrder, true, true>(ring, g, S, E, F.tid); }
    PH_END;
    if (PH_ON) { FRAME(); phase_ln(F, b * TB, TB, F.in(22) + l * D, F.in(23) + l * D); }
    PH_END;
}
template <int ch> __device__ __forceinline__ void moe_chunk_phases(const KState& K, int& pid) {
    if (PH_ON) { FRAME(); const int* BLKE = wsp<int>(F, WS_BLKE); int nb = BLKE[NBLK_MAX] - ch * MOE_CH; nb = nb < 0 ? 0 : (nb > MOE_CH ? MOE_CH : nb);
        if (nb > 0) { pg8::Gemm g{wsp<bf16>(F, WS_XG), wsp<bf16>(F, WS_MOEWGU), nb * 256, 2 * DFF, D}; pg8::MoeOrder S; S.init(nb * 256, 2 * DFF, F.G, cid); S.blk0 = ch * MOE_CH; S.blke = BLKE;
            pg8::EpiSwiglu E{wsp<bf16>(F, WS_HCH) - (size_t)ch * MOE_CH * 256 * DFF, DFF}; pg8::gemm_phase<pg8::EpiSwiglu, pg8::MoeOrder, true, true>(ring, g, S, E, F.tid); } }
    PH_END;
    if (PH_ON) { FRAME(); const int* BLKE = wsp<int>(F, WS_BLKE); int nb = BLKE[NBLK_MAX] - ch * MOE_CH; nb = nb < 0 ? 0 : (nb > MOE_CH ? MOE_CH : nb);
        if (nb > 0) { pg8::Gemm g{wsp<bf16>(F, WS_HCH) - (size_t)ch * MOE_CH * 256 * DFF, wsp<bf16>(F, WS_MOEWD), nb * 256, D, DFF}; pg8::MoeOrder S; S.init(nb * 256, D, F.G, cid); S.blk0 = ch * MOE_CH; S.blke = BLKE;
            pg8::EpiBf16 E{wsp<bf16>(F, WS_XG), D}; pg8::gemm_phase<pg8::EpiBf16, pg8::MoeOrder, true, true>(ring, g, S, E, F.tid); } }
    PH_END;
}
__global__ void __launch_bounds__(NWAVES * 64, 2) fwd(Args args) {
    extern __shared__ __attribute__((aligned(16))) unsigned char lds[];
    KState K;
    K.L = (LAS unsigned char*)lds; K.ws = args.ws; K.out = args.out; K.lo = args.ph_lo; K.hi = args.ph_hi;
    volatile LAS unsigned* MISC = (volatile LAS unsigned*)(K.L + MISC_OFF);
    K.wave_s = __builtin_amdgcn_readfirstlane((int)threadIdx.x >> 6);
    for (int u = K.wave_s * 64 + lane_id(); u < (LDS_BYTES - RING_BYTES) / 4; u += NWAVES * 64) ((LAS unsigned*)(K.L + RING_BYTES))[u] = 0u;
    __syncthreads();
    unsigned* const barw = (unsigned*)(args.ws + WS_CTL) + CW_BAR;
    K.bar.bar = barw; K.bar.x = 0; K.bar.st = nullptr;
    if (K.hi - K.lo > 1) K.bar = xcd_barrier_post(barw, MISC + 8, K.wave_s == 0 && lane_id() == 0);
    int pid = 0;

    if (PH_ON) { FRAME(); p0_prologue(F); }
    PH_END;
    mixer_phases<0, 0>(K, pid);
    mixer_phases<0, 1>(K, pid);
    {
        if (PH_ON) { FRAME(); pg8::Gemm g{wsp<bf16>(F, WS_XB), wsp<bf16>(F, WS_WGU), M, 2 * DFF, D}; pg8::StaticOrder S; S.init(M, 2 * DFF, F.G, cid);
            pg8::EpiSwiglu E{wsp<bf16>(F, WS_H), DFF}; pg8::gemm_phase<pg8::EpiSwiglu, pg8::StaticOrder, true, true>(ring, g, S, E, F.tid); }
        PH_END;
        if (PH_ON) { FRAME(); pg8::Gemm g{wsp<bf16>(F, WS_H), wsp<bf16>(F, WS_WD), M, D, DFF}; pg8::StaticOrder S; S.init(M, D, F.G, cid);
            pg8::EpiResid E{F.out, F.out, ALPHA}; pg8::gemm_phase<pg8::EpiResid, pg8::StaticOrder, true, true>(ring, g, S, E, F.tid); }
        PH_END;
        if (PH_ON) { FRAME(); phase_ln(F, 0, M, F.in(31), F.in(32)); }
        PH_END;
    }
    mixer_phases<1, 0>(K, pid);
    mixer_phases<1, 1>(K, pid);
    {
        if (PH_ON) { FRAME(); moe_weights(F); __syncthreads(); phase_router(F); }
        PH_END;
        if (PH_ON) { FRAME(); phase_assign(F); }
        PH_END;
        moe_chunk_phases<0>(K, pid); moe_chunk_phases<1>(K, pid); moe_chunk_phases<2>(K, pid); moe_chunk_phases<3>(K, pid); moe_chunk_phases<4>(K, pid);
        if (PH_ON) { FRAME(); phase_combine(F, F.in(31) + D, F.in(32) + D); }
        PH_END;
    }
}
#undef PH_ON
#undef PH_END
#undef FRAME

extern "C" void kernel_launch(void* const* d_in, const int* in_sizes, int n_in, void* d_out, int out_size, void* d_ws, size_t ws_size, hipStream_t stream) {
    static int grid = 0;
    if (grid == 0) {
        if (n_in != 33 || in_sizes[0] != M * D || out_size != M * D || ws_size < WS_END) { fprintf(stderr, "kernel_launch: unexpected shapes / workspace (n_in %d, ws %zu)\n", n_in, ws_size); grid = -1; return; }
        int dev = 0, cus = 0, per_cu = 0;
        if (hipGetDevice(&dev) != hipSuccess || hipDeviceGetAttribute(&cus, hipDeviceAttributeMultiprocessorCount, dev) != hipSuccess) { grid = -1; return; }
        if (hipFuncSetAttribute((const void*)fwd, hipFuncAttributeMaxDynamicSharedMemorySize, LDS_BYTES) != hipSuccess) { fprintf(stderr, "kernel_launch: hipFuncSetAttribute failed\n"); grid = -1; return; }
        if (hipOccupancyMaxActiveBlocksPerMultiprocessor(&per_cu, (const void*)fwd, NWAVES * 64, LDS_BYTES) != hipSuccess || per_cu < 1) fprintf(stderr, "kernel_launch: occupancy query reports %d\n", per_cu);
        (void)hipGetLastError();
        grid = cus;
    }
    if (grid < 0) return;
    if (hipMemsetAsync((char*)d_ws + WS_CTL, 0, CTL_ZERO_BYTES, stream) != hipSuccess) return;
    Args a{};
    for (int i = 0; i < 33; ++i) a.in[i] = (const float*)d_in[i];
    a.out = (float*)d_out; a.ws = (unsigned char*)d_ws;
#if MK_ONE_LAUNCH
    a.ph_lo = 0; a.ph_hi = NPH;
    hipLaunchKernelGGL(fwd, dim3(grid), dim3(NWAVES * 64), LDS_BYTES, stream, a);
#else
    for (int p = 0; p < NPH; ++p) { a.ph_lo = p; a.ph_hi = p + 1; hipLaunchKernelGGL(fwd, dim3(grid), dim3(NWAVES * 64), LDS_BYTES, stream, a); }
#endif
}
```

```cpp
#include <hip/hip_runtime.h>
#include <cstdio>
#include <cstdint>
namespace pg8 {
#define PG8_LAS __attribute__((address_space(3)))
typedef unsigned short bf16_t;
typedef short bf16x8 __attribute__((ext_vector_type(8)));
typedef float f32x4 __attribute__((ext_vector_type(4)));
typedef unsigned u32x4 __attribute__((ext_vector_type(4)));
typedef unsigned u32x2 __attribute__((ext_vector_type(2)));
constexpr int BM = 256, BK = 64, HALF = 128, HTB = HALF * BK * 2  , STAGE_BYTES = 8 * HTB, NXCD = 8, WGM = 8;

__host__ __device__ __forceinline__ int lds_byte(int r, int c) { const int st = (r >> 4) * 2 + (c >> 5), rr = r & 15, cc = c & 31, ob = rr * 64 + cc * 2; return st * 1024 + (ob ^ (((ob >> 9) & 1) << 5)); }
__host__ __device__ __forceinline__ void stage_rc(int b, int& R, int& C) { const int st = b / 1024, sb = b % 1024, swz = sb ^ (((sb >> 9) & 1) << 5); R = (st >> 1) * 16 + swz / 64; C = (st & 1) * 32 + (swz % 64) / 2; }
__host__ __device__ __forceinline__ int perm32(int rho) { const int n = rho >> 4, i = rho & 15; return 8 * (i >> 2) + 4 * n + (i & 3); }

struct Unit { int pm, pn, pb; };
struct Gemm { const bf16_t* A; const bf16_t* Bt; int M, N, K; };

struct StaticOrder {
    int nM, nN, nwg, G, c;
    __host__ __device__ void init(int M, int N, int G_, int c_) { nM = M / BM; nN = N / BM; nwg = nM * nN; G = G_; c = c_; }
    __host__ __device__ bool next(int i, Unit& u) const {
        const long L = (long)i * G + c; if (L >= nwg) return false;
        int wgid = (int)L; { const int q = nwg / NXCD, r = nwg % NXCD, xcd = wgid % NXCD, off = wgid / NXCD; wgid = (xcd < r ? xcd * (q + 1) : r * (q + 1) + (xcd - r) * q) + off; }
        const int nig = WGM * nN, gid = wgid / nig, fm = gid * WGM, gsz = (nM - fm) < WGM ? (nM - fm) : WGM;
        u.pm = fm + ((wgid % nig) % gsz); u.pn = (wgid % nig) / gsz; u.pb = u.pn; return true;
    }
    __device__ __forceinline__ void a_ready(const Unit&) const {}
    __device__ __forceinline__ void done(const Unit&) const {}
};
struct MoeOrder : StaticOrder {
    int blk0; const int* blke;
    __device__ __forceinline__ bool next(int i, Unit& u) const {
        if (!StaticOrder::next(i, u)) return false;
        u.pm += blk0; u.pb = blke[u.pm] * nN + u.pn; return true;
    }
};

__device__ __forceinline__ unsigned cvt_pk_bf16(float lo, float hi) { unsigned r; asm volatile("v_cvt_pk_bf16_f32 %0, %1, %2" : "=v"(r) : "v"(lo), "v"(hi)); return r; }
__device__ __forceinline__ float sigm(float x) { return __builtin_amdgcn_rcpf(1.f + __builtin_amdgcn_exp2f(-1.44269504f * x)); }
__device__ __forceinline__ float bflo(unsigned w) { return __uint_as_float(w << 16); }
__device__ __forceinline__ float bfhi(unsigned w) { return __uint_as_float(w & 0xffff0000u); }

#define PG8_ROWS(ai, m) for (int ai = 0; ai < 2; ++ai) _Pragma("unroll") for (int m = 0; m < 4; ++m)

struct EpiBf16 {
    static constexpr bool PERM = true, AFTER_DRAIN = false;
    bf16_t* O; int ldc;
    __device__ __forceinline__ void operator()(const f32x4 (&acc)[2][2][4][2], const Unit& u, int wr, int wc, int fr, int fq) const {
        const int row0 = u.pm * BM + wr * 64 + fr, col0 = u.pn * BM + wc * 32 + 8 * fq;
#pragma unroll
        PG8_ROWS(ai, m) { bf16_t* rowp = O + (size_t)(row0 + ai * HALF + m * 16) * ldc + col0;
#pragma unroll
            for (int bj = 0; bj < 2; ++bj) { const f32x4 v0 = acc[ai][bj][m][0], v1 = acc[ai][bj][m][1];
                u32x4 w; w.x = cvt_pk_bf16(v0[0], v0[1]); w.y = cvt_pk_bf16(v0[2], v0[3]); w.z = cvt_pk_bf16(v1[0], v1[1]); w.w = cvt_pk_bf16(v1[2], v1[3]);
                *(u32x4*)(rowp + bj * HALF) = w; } }
    }
};
struct EpiPG {
    static constexpr bool PERM = true, AFTER_DRAIN = false;
    bf16_t* P; bf16_t* G;
    __device__ __forceinline__ void operator()(const f32x4 (&acc)[2][2][4][2], const Unit& u, int wr, int wc, int fr, int fq) const {
        const int row0 = u.pm * BM + wr * 64 + fr; int colt = u.pn * BM; const bool isg = colt >= 3072; bf16_t* base = isg ? G : P; if (isg) colt -= 3072;
        const int col0 = colt + wc * 32 + 8 * fq;
#pragma unroll
        PG8_ROWS(ai, m) { bf16_t* rowp = base + (size_t)(row0 + ai * HALF + m * 16) * 3072 + col0;
#pragma unroll
            for (int bj = 0; bj < 2; ++bj) { f32x4 v0 = acc[ai][bj][m][0], v1 = acc[ai][bj][m][1];
                if (isg) {
#pragma unroll
                    for (int j = 0; j < 4; ++j) { v0[j] = sigm(v0[j]); v1[j] = sigm(v1[j]); } }
                u32x4 w; w.x = cvt_pk_bf16(v0[0], v0[1]); w.y = cvt_pk_bf16(v0[2], v0[3]); w.z = cvt_pk_bf16(v1[0], v1[1]); w.w = cvt_pk_bf16(v1[2], v1[3]);
                *(u32x4*)(rowp + bj * HALF) = w; } }
    }
};
struct EpiLora {
    static constexpr bool PERM = true, AFTER_DRAIN = false;
    float* LD; bf16_t* AA; long gg_off; const float* w0; const float* a0;
    __device__ __forceinline__ void operator()(const f32x4 (&acc)[2][2][4][2], const Unit& u, int wr, int wc, int fr, int fq) const {
        const int row0 = u.pm * BM + wr * 64 + fr; const int kind = u.pn >> 1; const int col0 = (u.pn & 1) * BM + wc * 32 + 8 * fq;
        const float* bias = (kind == 0 ? w0 : a0) + col0; const float bs = kind == 2 ? 0.f : 1.f;
#pragma unroll
        PG8_ROWS(ai, m) { const size_t ro = (size_t)(row0 + ai * HALF + m * 16) * 512 + col0;
#pragma unroll
            for (int bj = 0; bj < 2; ++bj) { f32x4 v0 = acc[ai][bj][m][0] + *(const f32x4*)(bias + bj * HALF) * bs, v1 = acc[ai][bj][m][1] + *(const f32x4*)(bias + bj * HALF + 4) * bs;
                if (kind == 0) {
#pragma unroll
                    for (int j = 0; j < 4; ++j) {
                        { const float y = -v0[j]; const float sp = fmaxf(y, 0.f) + __logf(1.f + __expf(-fabsf(y))); v0[j] = -__expf(-sp - 0.5f); }
                        { const float y = -v1[j]; const float sp = fmaxf(y, 0.f) + __logf(1.f + __expf(-fabsf(y))); v1[j] = -__expf(-sp - 0.5f); } }
                    *(f32x4*)(LD + ro + bj * HALF) = v0; *(f32x4*)(LD + ro + bj * HALF + 4) = v1;
                } else {
                    if (kind == 1) {
#pragma unroll
                        for (int j = 0; j < 4; ++j) { v0[j] = sigm(v0[j]); v1[j] = sigm(v1[j]); } }
                    u32x4 w; w.x = cvt_pk_bf16(v0[0], v0[1]); w.y = cvt_pk_bf16(v0[2], v0[3]); w.z = cvt_pk_bf16(v1[0], v1[1]); w.w = cvt_pk_bf16(v1[2], v1[3]);
                    *(u32x4*)(AA + (kind == 1 ? 0l : gg_off) + ro + bj * HALF) = w; } }
            asm volatile("" ::: "memory"); }
    }
};
template <int MODE> struct EpiMerge {
    static constexpr bool PERM = true, AFTER_DRAIN = false;
    const bf16_t* G; int gcol0; float* MRG; bf16_t* MRGB;
    __device__ __forceinline__ void operator()(const f32x4 (&acc)[2][2][4][2], const Unit& u, int wr, int wc, int fr, int fq) const {
        const int row0 = u.pm * BM + wr * 64 + fr, col0 = u.pn * BM + wc * 32 + 8 * fq;
#pragma unroll
        PG8_ROWS(ai, m) { const size_t row = (size_t)(row0 + ai * HALF + m * 16);
#pragma unroll
            for (int bj = 0; bj < 2; ++bj) { const int col = col0 + bj * HALF;
                const u32x4 gw = *(const u32x4*)(G + row * 3072 + gcol0 + col);
                f32x4 v0 = acc[ai][bj][m][0], v1 = acc[ai][bj][m][1];
                v0[0] *= bflo(gw.x); v0[1] *= bfhi(gw.x); v0[2] *= bflo(gw.y); v0[3] *= bfhi(gw.y); v1[0] *= bflo(gw.z); v1[1] *= bfhi(gw.z); v1[2] *= bflo(gw.w); v1[3] *= bfhi(gw.w);
                float* mp = MRG + row * 1024 + col;
                if (MODE >= 1) { v0 += *(const f32x4*)mp; v1 += *(const f32x4*)(mp + 4); }
                if (MODE <= 1) { *(f32x4*)mp = v0; *(f32x4*)(mp + 4) = v1; }
                else { u32x4 w; w.x = cvt_pk_bf16(v0[0], v0[1]); w.y = cvt_pk_bf16(v0[2], v0[3]); w.z = cvt_pk_bf16(v1[0], v1[1]); w.w = cvt_pk_bf16(v1[2], v1[3]); *(u32x4*)(MRGB + row * 1024 + col) = w; } } }
    }
};
struct EpiResid {
    static constexpr bool PERM = false, AFTER_DRAIN = false;
    const float* src; float* out; float alpha;
    __device__ __forceinline__ void operator()(const f32x4 (&acc)[2][2][4][2], const Unit& u, int wr, int wc, int fr, int fq) const {
        const int row0 = u.pm * BM + wr * 64 + fr, col0 = u.pn * BM + wc * 32 + 4 * fq;
#pragma unroll
        PG8_ROWS(ai, m) { const size_t off = (size_t)(row0 + ai * HALF + m * 16) * 1024 + col0;
#pragma unroll
            for (int bj = 0; bj < 2; ++bj)
#pragma unroll
                for (int n = 0; n < 2; ++n) { const f32x4 s = *(const f32x4*)(src + off + bj * HALF + n * 16); *(f32x4*)(out + off + bj * HALF + n * 16) = s * alpha + acc[ai][bj][m][n]; } }
    }
};
struct EpiSwiglu {
    static constexpr bool PERM = true, AFTER_DRAIN = false;
    bf16_t* H; int ldc;
    __device__ __forceinline__ void operator()(const f32x4 (&acc)[2][2][4][2], const Unit& u, int wr, int wc, int fr, int fq) const {
        const int row0 = u.pm * BM + wr * 64 + fr, col0 = u.pn * HALF + wc * 32 + 8 * fq;
#pragma unroll
        PG8_ROWS(ai, m) { bf16_t* rowp = H + (size_t)(row0 + ai * HALF + m * 16) * ldc + col0;
            f32x4 v0 = acc[ai][0][m][0], v1 = acc[ai][0][m][1]; const f32x4 u0 = acc[ai][1][m][0], u1 = acc[ai][1][m][1];
#pragma unroll
            for (int j = 0; j < 4; ++j) { v0[j] = v0[j] * sigm(v0[j]) * u0[j]; v1[j] = v1[j] * sigm(v1[j]) * u1[j]; }
            u32x4 w; w.x = cvt_pk_bf16(v0[0], v0[1]); w.y = cvt_pk_bf16(v0[2], v0[3]); w.z = cvt_pk_bf16(v1[0], v1[1]); w.w = cvt_pk_bf16(v1[2], v1[3]);
            *(u32x4*)rowp = w; }
    }
};
template <class Epi, class Sched, bool ALIGN_EPI = false, bool SP2 = false>
__device__ __forceinline__ void gemm_phase(PG8_LAS unsigned char* lds, const Gemm g, const Sched& S, const Epi& E, const int tid) {
    const int wid = __builtin_amdgcn_readfirstlane(tid >> 6), lane = tid & 63, wr = wid >> 2, wc = wid & 3, fr = lane & 15, fq = lane >> 4;
    const int K = g.K, nt = K / BK;
    unsigned voffA[2], voffB[2];
#pragma unroll
    for (int i = 0; i < 2; ++i) { int R, C; stage_rc(tid * 16 + i * 8192, R, C); const int Rb = Epi::PERM ? ((R & ~31) + perm32(R & 31)) : R;
        voffA[i] = (unsigned)(R * K + C) * 2u; voffB[i] = (unsigned)(Rb * K + C) * 2u; }
    const size_t kstep = (size_t)(BK * 2);
    const size_t hstep = (size_t)HALF * K * 2;
    const size_t tstep = 2 * hstep;
    const unsigned ldsw = (unsigned)wid * 1024u;
    const int aoff = lds_byte(wr * 64 + fr, fq * 8), boff = lds_byte(wc * 32 + fr, fq * 8);
#define PG8_SA(b, h) (((b) * 2 + (h)) * HTB)
#define PG8_SB(b, h) ((4 + (b) * 2 + (h)) * HTB)
#define PG8_STAGE(bufoff, gbase, voff) do { _Pragma("unroll") for (int _i = 0; _i < 2; ++_i) \
        __builtin_amdgcn_global_load_lds((const unsigned*)((const char*)(gbase) + (voff)[_i]), (PG8_LAS unsigned*)(lds + (bufoff) + ldsw + _i * 8192), 16, 0, 0); } while (0)
#define PG8_LDA(dst, b, h) do { _Pragma("unroll") for (int m = 0; m < 4; ++m) _Pragma("unroll") for (int k = 0; k < 2; ++k) dst[m][k] = *(const PG8_LAS bf16x8*)(lds + PG8_SA(b, h) + aoff + m * 2048 + k * 1024); } while (0)
#define PG8_LDB(dst, b, h) do { _Pragma("unroll") for (int n = 0; n < 2; ++n) _Pragma("unroll") for (int k = 0; k < 2; ++k) dst[n][k] = *(const PG8_LAS bf16x8*)(lds + PG8_SB(b, h) + boff + n * 2048 + k * 1024); } while (0)
#define PG8_MMA(ai, bj, At, Bt) do { __builtin_amdgcn_s_setprio(1); _Pragma("unroll") for (int m = 0; m < 4; ++m) _Pragma("unroll") for (int n = 0; n < 2; ++n) _Pragma("unroll") for (int k = 0; k < 2; ++k) \
        acc[ai][bj][m][n] = __builtin_amdgcn_mfma_f32_16x16x32_bf16(Bt[n][k], At[m][k], acc[ai][bj][m][n], 0, 0, 0); __builtin_amdgcn_s_setprio(0); } while (0)
#define PG8_WAIT_V(n) asm volatile("s_waitcnt vmcnt(" #n ")" ::: "memory")
#define PG8_WAIT_L(n) asm volatile("s_waitcnt lgkmcnt(" #n ")" ::: "memory")
#define PG8_BAR __builtin_amdgcn_s_barrier()
#define PG8_SCHED __builtin_amdgcn_sched_barrier(0)
    Unit cur, nxt; int ui = 0;
    if (!S.next(0, cur)) return;
    f32x4 acc[2][2][4][2];
#pragma unroll
    for (int a = 0; a < 2; ++a)
#pragma unroll
        for (int b = 0; b < 2; ++b)
#pragma unroll
            for (int m = 0; m < 4; ++m)
#pragma unroll
                for (int n = 0; n < 2; ++n) acc[a][b][m][n] = (f32x4){0.f, 0.f, 0.f, 0.f};
    bf16x8 At[4][2], B0[2][2], B1[2][2];
    const char* cA = (const char*)g.A + (size_t)cur.pm * tstep; const char* cB = (const char*)g.Bt + (size_t)cur.pb * tstep;
    S.a_ready(cur);
    if constexpr (SP2) {
        PG8_STAGE(PG8_SB(0, 0), cB, voffB); PG8_STAGE(PG8_SB(0, 1), cB + hstep, voffB); PG8_STAGE(PG8_SA(0, 0), cA, voffA); PG8_STAGE(PG8_SA(0, 1), cA + hstep, voffA);
        if (wr == 1) PG8_BAR;
        PG8_WAIT_V(2); PG8_BAR;
        PG8_STAGE(PG8_SB(1, 0), cB + kstep, voffB); PG8_STAGE(PG8_SA(1, 0), cA + kstep, voffA); PG8_STAGE(PG8_SB(1, 1), cB + hstep + kstep, voffB);
        PG8_WAIT_V(6); PG8_BAR;
    } else {
        PG8_STAGE(PG8_SB(0, 0), cB, voffB); PG8_STAGE(PG8_SA(0, 0), cA, voffA); PG8_STAGE(PG8_SB(0, 1), cB + hstep, voffB); PG8_STAGE(PG8_SA(0, 1), cA + hstep, voffA);
        if (wr == 1) PG8_BAR;
        PG8_WAIT_V(4); PG8_BAR;
        PG8_STAGE(PG8_SB(1, 0), cB + kstep, voffB); PG8_STAGE(PG8_SA(1, 0), cA + kstep, voffA); PG8_STAGE(PG8_SB(1, 1), cB + hstep + kstep, voffB);
        PG8_WAIT_V(6); PG8_BAR;
    }
    for (;;) {
        const bool has_next = S.next(ui + 1, nxt);
        const char* nA = has_next ? (const char*)g.A + (size_t)nxt.pm * tstep : cA; const char* nB = has_next ? (const char*)g.Bt + (size_t)nxt.pb * tstep : cB;
        for (int t = 0; t < nt; t += 2) {
            const bool last = (t == nt - 2);
            const char* a1 = cA + (size_t)(t + 1) * kstep;
            const char* a2 = last ? nA : cA + (size_t)(t + 2) * kstep; const char* b2 = last ? nB : cB + (size_t)(t + 2) * kstep;
            const char* a3 = a2 + kstep; const char* b3 = b2 + kstep;
            if (last && has_next) S.a_ready(nxt);
            if constexpr (SP2) {
            PG8_LDB(B0, 0, 0); PG8_LDB(B1, 0, 1); PG8_SCHED; PG8_LDA(At, 0, 0); PG8_STAGE(PG8_SA(1, 1), a1 + hstep, voffA);
            PG8_WAIT_V(8); PG8_WAIT_L(0); PG8_BAR; PG8_MMA(0, 0, At, B0); PG8_MMA(0, 1, At, B1); PG8_BAR; PG8_SCHED;
            PG8_LDA(At, 0, 1); PG8_STAGE(PG8_SB(0, 0), b2, voffB); PG8_STAGE(PG8_SB(0, 1), b2 + hstep, voffB); PG8_STAGE(PG8_SA(0, 0), a2, voffA);
            PG8_WAIT_V(8); PG8_WAIT_L(0); PG8_BAR; PG8_MMA(1, 0, At, B0); PG8_MMA(1, 1, At, B1); PG8_BAR; PG8_SCHED;
            PG8_LDB(B0, 1, 0); PG8_LDB(B1, 1, 1); PG8_SCHED; PG8_LDA(At, 1, 0); PG8_STAGE(PG8_SA(0, 1), a2 + hstep, voffA);
            PG8_WAIT_V(8); PG8_WAIT_L(0); PG8_BAR; PG8_MMA(0, 0, At, B0); PG8_MMA(0, 1, At, B1); PG8_BAR; PG8_SCHED;
            PG8_LDA(At, 1, 1); PG8_STAGE(PG8_SB(1, 0), b3, voffB); PG8_STAGE(PG8_SB(1, 1), b3 + hstep, voffB); PG8_STAGE(PG8_SA(1, 0), a3, voffA);
            PG8_WAIT_V(8); PG8_WAIT_L(0); PG8_BAR; PG8_MMA(1, 0, At, B0); PG8_MMA(1, 1, At, B1); PG8_BAR; PG8_SCHED;
            } else {
            PG8_LDB(B0, 0, 0); PG8_SCHED; PG8_LDA(At, 0, 0); PG8_STAGE(PG8_SA(1, 1), a1 + hstep, voffA);
            PG8_WAIT_L(8); PG8_BAR; PG8_WAIT_L(0); PG8_MMA(0, 0, At, B0); PG8_BAR; PG8_SCHED;
            PG8_LDB(B1, 0, 1); PG8_STAGE(PG8_SB(0, 0), b2, voffB);
            PG8_BAR; PG8_WAIT_L(0); PG8_MMA(0, 1, At, B1); PG8_BAR;
            PG8_LDA(At, 0, 1); PG8_STAGE(PG8_SA(0, 0), a2, voffA);
            PG8_BAR; PG8_WAIT_L(0); PG8_MMA(1, 0, At, B0); PG8_BAR; PG8_SCHED;
            PG8_STAGE(PG8_SB(0, 1), b2 + hstep, voffB);
            PG8_WAIT_V(6); PG8_BAR; PG8_MMA(1, 1, At, B1); PG8_BAR;
            PG8_LDB(B0, 1, 0); PG8_SCHED; PG8_LDA(At, 1, 0); PG8_STAGE(PG8_SA(0, 1), a2 + hstep, voffA);
            PG8_WAIT_L(8); PG8_BAR; PG8_WAIT_L(0); PG8_MMA(0, 0, At, B0); PG8_BAR; PG8_SCHED;
            PG8_LDB(B1, 1, 1); PG8_STAGE(PG8_SB(1, 0), b3, voffB);
            PG8_BAR; PG8_WAIT_L(0); PG8_MMA(0, 1, At, B1); PG8_BAR;
            PG8_LDA(At, 1, 1); PG8_STAGE(PG8_SA(1, 0), a3, voffA);
            PG8_BAR; PG8_WAIT_L(0); PG8_MMA(1, 0, At, B0); PG8_BAR; PG8_SCHED;
            PG8_STAGE(PG8_SB(1, 1), b3 + hstep, voffB);
            PG8_WAIT_V(6); PG8_BAR; PG8_MMA(1, 1, At, B1); PG8_BAR;
            }
        }
        if constexpr (ALIGN_EPI) { if (wr == 0) PG8_BAR; }
        if constexpr (!Epi::AFTER_DRAIN) { E(acc, cur, wr, wc, fr, fq); S.done(cur); }
        if (!has_next) break;
#pragma unroll
        for (int a = 0; a < 2; ++a)
#pragma unroll
            for (int b = 0; b < 2; ++b)
#pragma unroll
                for (int m = 0; m < 4; ++m)
#pragma unroll
                    for (int n = 0; n < 2; ++n) acc[a][b][m][n] = (f32x4){0.f, 0.f, 0.f, 0.f};
        cur = nxt; cA = nA; cB = nB; ++ui;
        if constexpr (ALIGN_EPI) { if (wr == 1) PG8_BAR; }
    }
    PG8_WAIT_V(0);
    if constexpr (!ALIGN_EPI) { if (wr == 0) PG8_BAR; }
    PG8_BAR;
    if constexpr (Epi::AFTER_DRAIN) { E.fused(acc, cur, wr, wc, fr, fq, lds, wid, lane); S.done(cur); }
#undef PG8_SA
#undef PG8_SB
#undef PG8_STAGE
#undef PG8_LDA
#undef PG8_LDB
#undef PG8_MMA
#undef PG8_WAIT_V
#undef PG8_WAIT_L
#undef PG8_BAR
#undef PG8_SCHED
}
}

#ifndef MK_ONE_LAUNCH
#define MK_ONE_LAUNCH 1
#endif
constexpr int NWAVES = 8;
constexpr int BATCH = 2, SEQ = 16384, D = 1024, M = BATCH * SEQ, TB = SEQ;
constexpr int RW = 512, NH = 8, HD = 64, PC = 3072, DFF = 2816, NE = 8, NBLK_MAX = 264, MOE_CH = 64, MOE_NCH = 5;
constexpr float LN_EPS = 1e-5f, GN_EPS = 64e-5f, ALPHA = 1.41421356237f;
constexpr size_t MiB = 1u << 20;
constexpr size_t WS_CTL = 0, CTL_ZERO_BYTES = 1 * MiB;
constexpr size_t WS_WIN = 1 * MiB, WS_WOUT = 25 * MiB, WS_WOA = 29 * MiB, WS_WOB = 31 * MiB, WS_WOC = 32 * MiB, WS_WLORA = 33 * MiB, WS_WGU = 35 * MiB, WS_WD = 46 * MiB;
constexpr size_t WS_XB = 52 * MiB, WS_ACT = 116 * MiB;
constexpr size_t WS_P = WS_ACT, WS_G = 212 * MiB, WS_LA = 308 * MiB, WS_LD = 316 * MiB, WS_AA = 348 * MiB, WS_GG = 364 * MiB, WS_O = 380 * MiB, WS_OA = 412 * MiB, WS_UB = 428 * MiB, WS_UC = 436 * MiB;
constexpr size_t WS_MRG = WS_ACT, WS_MRGB = 180 * MiB;
constexpr size_t WS_H = WS_ACT;
constexpr size_t WS_MOEWGU = WS_ACT, WS_MOEWD = 204 * MiB, WS_XG = 248 * MiB, WS_HCH = 380 * MiB, WS_TOKE = 470 * MiB, WS_TOKW = 471 * MiB, WS_SLOT = 472 * MiB, WS_BLKE = 473 * MiB;
constexpr size_t WS_END = 490 * MiB;
constexpr int CW_TMO = 0, CW_BAR = 4096, CW_MOE = 16384;
constexpr int RING_BYTES = 131072, MISC_OFF = RING_BYTES + 320, LDS_BYTES = 147456;

#define GAS __attribute__((address_space(1)))
#define LAS __attribute__((address_space(3)))
typedef unsigned short bf16;
typedef unsigned v4u __attribute__((ext_vector_type(4)));
typedef unsigned v2u __attribute__((ext_vector_type(2)));
typedef float f32x4 __attribute__((ext_vector_type(4)));
typedef float f32x2 __attribute__((ext_vector_type(2)));
#define RLX_AGENT __ATOMIC_RELAXED, __HIP_MEMORY_SCOPE_AGENT
#define LDS_WAIT() asm volatile("s_waitcnt lgkmcnt(0)" ::: "memory")
using pg8::bflo; using pg8::bfhi; using pg8::sigm; using pg8::cvt_pk_bf16;

#define XB_TMO      128
#define XB_XCNT(j)  (256  + 64 * (j))
#define XB_XSUB(j)  (1280 + 64 * (j))
#define XB_XGEN(j)  (2304 + 64 * (j))
#define XB_TOP      3328
#define XB_TOPGEN   3392
#define XCD_BAR_WORDS 3456
#define XB_SPIN_CAP (1u << 18)
__device__ __forceinline__ unsigned xb_ld(unsigned* p)              { return __hip_atomic_load(p, __ATOMIC_RELAXED, __HIP_MEMORY_SCOPE_AGENT); }
__device__ __forceinline__ unsigned xb_add(unsigned* p, unsigned v) { return __hip_atomic_fetch_add(p, v, __ATOMIC_RELAXED, __HIP_MEMORY_SCOPE_AGENT); }
__device__ __forceinline__ unsigned xb_xcc_id() { return (unsigned)__builtin_amdgcn_s_getreg((3 << 11) | 20) & 0xFu; }
#define XB_SPIN(cond, bar) do { unsigned _sp = 0; while (cond) { __builtin_amdgcn_s_sleep(1); \
    if ((++_sp & 255u) == 0u) { if (xb_ld(&(bar)[XB_TMO])) break; if (_sp > XB_SPIN_CAP) { atomicAdd(&(bar)[XB_TMO], 1u); break; } } } } while (0)
struct XcdBarrier { unsigned* bar; unsigned x; volatile LAS unsigned* st; };
__device__ __forceinline__ XcdBarrier xcd_barrier_post(unsigned* bar, volatile LAS unsigned* st, bool leader) {
    XcdBarrier b; b.bar = bar; b.x = xb_xcc_id(); b.st = st;
    if (leader) (void)xb_add(&bar[XB_XCNT(b.x)], 1u);
    return b;
}
__device__ __forceinline__ void xcd_barrier_complete(unsigned* bar, unsigned x, unsigned& nloc, unsigned& nx) {
    const unsigned G = gridDim.x * gridDim.y * gridDim.z;
    unsigned sum, cnt, mine, sp = 0u;
    for (;;) {
        sum = 0u; cnt = 0u; mine = 0u;
#pragma unroll
        for (unsigned j = 0; j < 16; ++j) { const unsigned c = xb_ld(&bar[XB_XCNT(j)]); sum += c; cnt += (c > 0u) ? 1u : 0u; mine = (j == x) ? c : mine; }
        if (sum == G) break;
        __builtin_amdgcn_s_sleep(1);
        if ((++sp & 255u) == 0u) { if (xb_ld(&bar[XB_TMO])) break; if (sp > XB_SPIN_CAP) { atomicAdd(&bar[XB_TMO], 1u); break; } }
    }
    nloc = mine > 0u ? mine : 1u; nx = cnt > 0u ? cnt : 1u;
}
__device__ __forceinline__ void xcd_barrier(const XcdBarrier& b, bool leader) {
    asm volatile("s_waitcnt vmcnt(0)" ::: "memory");
    __syncthreads();
    if (leader) {
        unsigned* bar = b.bar;
        __builtin_amdgcn_s_waitcnt(0);
        unsigned nloc = b.st[0], nx = b.st[1];
        if (nloc == 0u) { xcd_barrier_complete(bar, b.x, nloc, nx); b.st[0] = nloc; b.st[1] = nx; }
        const unsigned old = xb_add(&bar[XB_XSUB(b.x)], 1u);
        const unsigned gen = old / nloc;
        if (old + 1u == (gen + 1u) * nloc) {
            __builtin_amdgcn_fence(__ATOMIC_RELEASE, "agent");
            asm volatile("s_waitcnt vmcnt(0)" ::: "memory");
            const unsigned og = xb_add(&bar[XB_TOP], 1u);
            const unsigned tg = og / nx;
            if (og + 1u == (tg + 1u) * nx) xb_add(&bar[XB_TOPGEN], 1u);
            else XB_SPIN(xb_ld(&bar[XB_TOPGEN]) == tg, bar);
            __builtin_amdgcn_fence(__ATOMIC_ACQUIRE, "agent");
            xb_add(&bar[XB_XGEN(b.x)], 1u);
            asm volatile("s_waitcnt vmcnt(0)" ::: "memory");
        } else {
            XB_SPIN(xb_ld(&bar[XB_XGEN(b.x)]) == gen, bar);
            __builtin_amdgcn_fence(__ATOMIC_ACQUIRE, "agent");
            asm volatile("s_waitcnt vmcnt(0)" ::: "memory");
        }
    }
    __syncthreads();
}

__device__ __forceinline__ float wave_sum(float v) {
#pragma unroll
    for (int o = 1; o < 64; o <<= 1) v += __shfl_xor(v, o);
    return v;
}
__device__ __forceinline__ float red8(float v) { v += __shfl_xor(v, 1); v += __shfl_xor(v, 2); v += __shfl_xor(v, 4); return v; }
__device__ __forceinline__ void ld8bf(const bf16* p, float (&o)[8]) { const v4u w = *(const v4u*)p; o[0] = bflo(w.x); o[1] = bfhi(w.x); o[2] = bflo(w.y); o[3] = bfhi(w.y); o[4] = bflo(w.z); o[5] = bfhi(w.z); o[6] = bflo(w.w); o[7] = bfhi(w.w); }
__device__ __forceinline__ void ld4bf(const bf16* p, float (&o)[4]) { const v2u w = *(const v2u*)p; o[0] = bflo(w.x); o[1] = bfhi(w.x); o[2] = bflo(w.y); o[3] = bfhi(w.y); }
__device__ __forceinline__ void ld8f(const float* p, float (&o)[8]) { const f32x4 a = *(const f32x4*)p, b = *(const f32x4*)(p + 4); o[0] = a[0]; o[1] = a[1]; o[2] = a[2]; o[3] = a[3]; o[4] = b[0]; o[5] = b[1]; o[6] = b[2]; o[7] = b[3]; }
__device__ __forceinline__ void ld4f(const float* p, float (&o)[4]) { const f32x4 a = *(const f32x4*)p; o[0] = a[0]; o[1] = a[1]; o[2] = a[2]; o[3] = a[3]; }
__device__ __forceinline__ void st8bf(bf16* p, const float (&v)[8]) { v4u w; w.x = cvt_pk_bf16(v[0], v[1]); w.y = cvt_pk_bf16(v[2], v[3]); w.z = cvt_pk_bf16(v[4], v[5]); w.w = cvt_pk_bf16(v[6], v[7]); *(v4u*)p = w; }
__device__ __forceinline__ void st4bf(bf16* p, const float (&v)[4]) { v2u w; w.x = cvt_pk_bf16(v[0], v[1]); w.y = cvt_pk_bf16(v[2], v[3]); *(v2u*)p = w; }
__device__ __forceinline__ void shift8(const bf16* Prow, bool hasprev, int col, const float* mu, float (&o)[8]) {
    float c[8], p[8], m[8]; ld8bf(Prow + col, c); ld8f(mu + col, m);
    if (hasprev) ld8bf(Prow - PC + col, p); else {
#pragma unroll
        for (int j = 0; j < 8; ++j) p[j] = 0.f; }
#pragma unroll
    for (int j = 0; j < 8; ++j) o[j] = c[j] + (p[j] - c[j]) * m[j];
}
__device__ __forceinline__ void shift4(const bf16* Prow, bool hasprev, int col, const float* mu, float (&o)[4]) {
    float c[4], p[4], m[4]; ld4bf(Prow + col, c); ld4f(mu + col, m);
    if (hasprev) ld4bf(Prow - PC + col, p); else {
#pragma unroll
        for (int j = 0; j < 4; ++j) p[j] = 0.f; }
#pragma unroll
    for (int j = 0; j < 4; ++j) o[j] = c[j] + (p[j] - c[j]) * m[j];
}

struct Frame {
    LAS unsigned char* lds;
    unsigned* ctl;
    int tid, lane, wave, vcu, G, gw, NGW;
    int z;
    float* out; unsigned char* ws;
    __device__ __forceinline__ const float* in(int k) const { typedef const float* const __attribute__((address_space(4))) * KP; KP kin = (KP)__builtin_amdgcn_kernarg_segment_ptr(); return (const float*)(const GAS float*)kin[k + z]; }
};
__device__ __forceinline__ int lane_id() { int l; asm volatile("v_mbcnt_lo_u32_b32 %0, -1, 0\n\tv_mbcnt_hi_u32_b32 %0, -1, %0" : "=v"(l)); return l; }
__device__ __forceinline__ void mkframe(Frame& F, LAS unsigned char* lds, unsigned char* ws, float* out, int wave_s) {
    int tid = wave_s * 64 + lane_id(); asm volatile("" : "+v"(tid));
    int z = 0; asm volatile("" : "+s"(z));
    F.lds = lds; F.z = z; F.tid = tid; F.lane = tid & 63; F.wave = wave_s;
    F.G = (int)gridDim.x + z; { const int bx = (int)blockIdx.x + z; F.vcu = (F.G % 8 == 0) ? (bx % 8) * (F.G / 8) + bx / 8 : bx; }
    F.gw = F.vcu * NWAVES + F.wave; F.NGW = F.G * NWAVES;
    F.ws = ws + z; F.out = out + z; F.ctl = (unsigned*)(F.ws + WS_CTL);
}
template <class T> __device__ __forceinline__ T* wsp(const Frame& F, size_t off) { return (T*)(F.ws + off); }

template <int MODE>
__device__ __forceinline__ void transpose_item(const float* W, int K, int N, bf16* WT, int row_off, LAS float* scr, int item, int lane) {
    const int nblk = N / 32, kb = item / nblk, nb = item % nblk, k0 = 64 * kb, n0 = 32 * nb;
#pragma unroll 8
    for (int i = 0; i < 32; ++i) { const int kk = 2 * i + (lane >> 5); scr[kk * 33 + (lane & 31)] = W[(size_t)(k0 + kk) * N + n0 + (lane & 31)]; }
    LDS_WAIT(); asm volatile("" ::: "memory");
    const int c = lane & 7;
    const int drow0 = MODE == 0 ? row_off + n0 : (n0 / 128) * 256 + (n0 % 128) + row_off;
#pragma unroll
    for (int j = 0; j < 4; ++j) { const int n = (lane >> 3) + 8 * j; const LAS float* s = scr + (8 * c) * 33 + n;
        v4u o; o.x = cvt_pk_bf16(s[0 * 33], s[1 * 33]); o.y = cvt_pk_bf16(s[2 * 33], s[3 * 33]); o.z = cvt_pk_bf16(s[4 * 33], s[5 * 33]); o.w = cvt_pk_bf16(s[6 * 33], s[7 * 33]);
        *(v4u*)(WT + (size_t)(drow0 + n) * K + k0 + 8 * c) = o; }
    LDS_WAIT(); asm volatile("" ::: "memory");
}
template <int MODE>
__device__ __forceinline__ void transpose_all(const Frame& F, const float* W, int K, int N, bf16* WT, int row_off) {
    LAS float* scr = (LAS float*)(F.lds + F.wave * 16384);
    const int nitems = (K / 64) * (N / 32);
    for (int it = F.gw; it < nitems; it += F.NGW) transpose_item<MODE>(W, K, N, WT, row_off, scr, it, F.lane);
}

__device__ __forceinline__ void p0_prologue(const Frame& F) {
    for (int l = 0; l < 2; ++l) {
        transpose_all<0>(F, F.in(1) + (size_t)l * D * 6144, D, 6144, wsp<bf16>(F, WS_WIN) + (size_t)l * 6144 * D, 0);
        transpose_all<0>(F, F.in(13) + (size_t)l * RW * D, RW, D, wsp<bf16>(F, WS_WOA) + (size_t)l * D * RW, 0);
        transpose_all<0>(F, F.in(18) + (size_t)l * 256 * D, 256, D, wsp<bf16>(F, WS_WOB) + (size_t)l * D * 256, 0);
        transpose_all<0>(F, F.in(20) + (size_t)l * 256 * D, 256, D, wsp<bf16>(F, WS_WOC) + (size_t)l * D * 256, 0);
        transpose_all<0>(F, F.in(21) + (size_t)l * D * D, D, D, wsp<bf16>(F, WS_WOUT) + (size_t)l * D * D, 0);
        bf16* WL = wsp<bf16>(F, WS_WLORA) + (size_t)l * (MiB / 2);
        const float* w2 = F.in(4) + (size_t)l * 64 * RW; const float* a2 = F.in(6) + (size_t)l * 64 * RW; const float* g2 = F.in(7) + (size_t)l * 128 * RW;
        for (int idx = F.gw * 64 + F.lane; idx < 1536 * 256; idx += F.NGW * 64) {
            const int n = idx >> 8, k = idx & 255; float v = 0.f;
            if (n < 512) { if (k < 64) v = w2[k * RW + n]; }
            else if (n < 1024) { if (k >= 64 && k < 128) v = a2[(k - 64) * RW + (n - 512)]; }
            else { if (k >= 128) v = g2[(k - 128) * RW + (n - 1024)]; }
            WL[idx] = (bf16)(cvt_pk_bf16(v, 0.f) & 0xffffu);
        }
    }
    transpose_all<1>(F, F.in(24), D, DFF, wsp<bf16>(F, WS_WGU), 0);
    transpose_all<1>(F, F.in(25), D, DFF, wsp<bf16>(F, WS_WGU), 128);
    transpose_all<0>(F, F.in(26), DFF, D, wsp<bf16>(F, WS_WD), 0);
    const float* x = F.in(0); bf16* xb = wsp<bf16>(F, WS_XB);
    for (size_t i = ((size_t)F.gw * 64 + F.lane) * 8; i < (size_t)M * D; i += (size_t)F.NGW * 64 * 8) { float v[8]; ld8f(x + i, v); st8bf(xb + i, v); }
}
__device__ __forceinline__ void moe_weights(const Frame& F) {
    for (int e = 0; e < NE; ++e) {
        transpose_all<1>(F, F.in(28) + (size_t)e * D * DFF, D, DFF, wsp<bf16>(F, WS_MOEWGU) + (size_t)e * 2 * DFF * D, 0);
        transpose_all<1>(F, F.in(29) + (size_t)e * D * DFF, D, DFF, wsp<bf16>(F, WS_MOEWGU) + (size_t)e * 2 * DFF * D, 128);
        transpose_all<0>(F, F.in(30) + (size_t)e * DFF * D, DFF, D, wsp<bf16>(F, WS_MOEWD) + (size_t)e * D * DFF, 0);
    }
}

__device__ __forceinline__ void phase_b(const Frame& F, int l) {
    const bf16* P = wsp<bf16>(F, WS_P);
    {
        LAS float* U = (LAS float*)F.lds; LAS float* DW = (LAS float*)(F.lds + 94 * 1024);
        const float* dw = F.in(14) + (size_t)l * 31 * 256; const float* dwb = F.in(15) + l * 256; const float* lg = F.in(16) + l * 256; const float* lb = F.in(17) + l * 256;
        bf16* UB = wsp<bf16>(F, WS_UB);
        for (int u = F.vcu; u < TB / 64; u += F.G) {
            const int t0 = u * 64;
            for (int idx = F.tid; idx < 94 * 32; idx += 512) { const int row = idx >> 5, g8 = idx & 31, t = t0 - 30 + row; float o[8];
                if (t >= 0) { float a[8], g[8]; ld8bf(P + (size_t)t * PC + 1792 + 8 * g8, a); ld8bf(P + (size_t)t * PC + 2048 + 8 * g8, g);
#pragma unroll
                    for (int j = 0; j < 8; ++j) o[j] = a[j] * sigm(g[j]); }
                else {
#pragma unroll
                    for (int j = 0; j < 8; ++j) o[j] = 0.f; }
                *(LAS f32x4*)(U + row * 256 + 8 * g8) = (f32x4){o[0], o[1], o[2], o[3]}; *(LAS f32x4*)(U + row * 256 + 8 * g8 + 4) = (f32x4){o[4], o[5], o[6], o[7]}; }
            for (int idx = F.tid; idx < 31 * 64; idx += 512) *(LAS f32x4*)(DW + 4 * idx) = *(const f32x4*)(dw + 4 * idx);
            __syncthreads();
            const int c = 4 * F.lane; const f32x4 bias = *(const f32x4*)(dwb + c), gg = *(const f32x4*)(lg + c), bb = *(const f32x4*)(lb + c);
            for (int i = 0; i < 8; ++i) { const int tt = F.wave * 8 + i; f32x4 acc = bias;
#pragma unroll
                for (int j = 0; j < 31; ++j) acc += *(const LAS f32x4*)(DW + j * 256 + c) * *(const LAS f32x4*)(U + (tt + j) * 256 + c);
                const float mean = wave_sum((acc[0] + acc[1]) + (acc[2] + acc[3])) * (1.f / 256.f); const f32x4 d = acc - mean;
                const float var = wave_sum((d[0] * d[0] + d[1] * d[1]) + (d[2] * d[2] + d[3] * d[3])) * (1.f / 256.f); const float rstd = 1.f / sqrtf(var + LN_EPS);
                float y[4];
#pragma unroll
                for (int j = 0; j < 4; ++j) { const float z = d[j] * rstd * gg[j] + bb[j]; y[j] = z * sigm(z); }
                st4bf(UB + (size_t)(t0 + tt) * 256 + c, y); }
            __syncthreads();
        }
    }
    {
        bf16* LA = wsp<bf16>(F, WS_LA); const float* mu = F.in(2) + (size_t)l * 1792;
        for (int tp = F.gw; tp < TB / 2; tp += F.NGW) { const int t = 2 * tp + (F.lane >> 5), j8 = F.lane & 31; float v[8];
            shift8(P + (size_t)t * PC, t > 0, 1536 + 8 * j8, mu, v);
            if (j8 < 8) {
#pragma unroll
                for (int j = 0; j < 8; ++j) v[j] = 1.f - 2.f * __builtin_amdgcn_rcpf(1.f + __expf(2.f * v[j])); }
            else if (j8 >= 16) {
#pragma unroll
                for (int j = 0; j < 8; ++j) v[j] = sigm(v[j]); }
            st8bf(LA + (size_t)t * 256 + 8 * j8, v); }
    }
    {
        bf16* UC = wsp<bf16>(F, WS_UC); const float* dw = F.in(19) + (size_t)l * 3 * 256;
        const int c = 4 * F.lane; f32x4 w[3];
#pragma unroll
        for (int d = 0; d < 3; ++d) w[d] = *(const f32x4*)(dw + d * 256 + c);
        for (int t = F.gw; t < TB; t += F.NGW) { float gb[4]; ld4bf(P + (size_t)t * PC + 2304 + c, gb); float acc[4] = {0.f, 0.f, 0.f, 0.f};
#pragma unroll
            for (int d = 0; d < 3; ++d) { const int tt = t - 2 + d; if (tt >= 0) { float gc[4], h[4]; ld4bf(P + (size_t)tt * PC + 2560 + c, gc); ld4bf(P + (size_t)tt * PC + 2816 + c, h);
#pragma unroll
                    for (int j = 0; j < 4; ++j) acc[j] += w[d][j] * gc[j] * h[j]; } }
#pragma unroll
            for (int j = 0; j < 4; ++j) acc[j] *= gb[j];
            st4bf(UC + (size_t)t * 256 + c, acc); }
    }
}

__device__ __forceinline__ void phase_scan_naive(const Frame& F, int l) {
    const int h = (int)blockIdx.x + F.z;
    if (h >= NH) return;
    const bf16* P = wsp<bf16>(F, WS_P); const bf16* AA = wsp<bf16>(F, WS_AA); const float* LD = wsp<float>(F, WS_LD); float* O = wsp<float>(F, WS_O);
    const float* mu = F.in(2) + (size_t)l * 1792; const float* k_k = F.in(8) + l * RW; const float* k_a = F.in(9) + l * RW;
    LAS float* L = (LAS float*)F.lds;
    const int tt = F.tid >> 4, cg = F.tid & 15, c = 4 * cg, col = h * HD + c;
    float kk4[4], ka4[4]; ld4f(k_k + col, kk4); ld4f(k_a + col, ka4);
    float r4[4], k4[4], v4[4], a4[4], ld4[4];
    auto load_block = [&](int blk) { const int t = blk * 32 + tt; const bf16* pr = P + (size_t)t * PC;
        shift4(pr, t > 0, col, mu, r4); shift4(pr, t > 0, 512 + col, mu, k4); shift4(pr, t > 0, 1024 + col, mu, v4);
        ld4bf(AA + (size_t)t * RW + col, a4); ld4f(LD + (size_t)t * RW + col, ld4); };
    auto write_block = [&](int buf) { LAS float* B = L + buf * (6 * 32 * 64) + tt * 64 + c;
        float kx[4], ss = 0.f;
#pragma unroll
        for (int j = 0; j < 4; ++j) { kx[j] = k4[j] * kk4[j]; ss += kx[j] * kx[j]; }
        ss += __shfl_xor(ss, 1); ss += __shfl_xor(ss, 2); ss += __shfl_xor(ss, 4); ss += __shfl_xor(ss, 8);
        const float inv = 1.f / fmaxf(sqrtf(ss), 1e-12f);
        f32x4 dec, kap, kb, kp;
#pragma unroll
        for (int j = 0; j < 4; ++j) { dec[j] = __expf(ld4[j]); kap[j] = kx[j] * inv; kb[j] = kap[j] * a4[j]; kp[j] = k4[j] * (1.f + (a4[j] - 1.f) * ka4[j]); }
        *(LAS f32x4*)(B + 0 * 2048) = dec; *(LAS f32x4*)(B + 1 * 2048) = kap; *(LAS f32x4*)(B + 2 * 2048) = kb; *(LAS f32x4*)(B + 3 * 2048) = kp;
        *(LAS f32x4*)(B + 4 * 2048) = (f32x4){r4[0], r4[1], r4[2], r4[3]}; *(LAS f32x4*)(B + 5 * 2048) = (f32x4){v4[0], v4[1], v4[2], v4[3]}; };
    const int vl = F.lane >> 3, kq = F.lane & 7, vrow = F.wave * 8 + vl, k0 = 8 * kq;
    float s[8];
#pragma unroll
    for (int j = 0; j < 8; ++j) s[j] = 0.f;
    load_block(0); write_block(0); __syncthreads();
    for (int blk = 0; blk < TB / 32; ++blk) {
        const int buf = blk & 1;
        if (blk + 1 < TB / 32) load_block(blk + 1);
        const LAS float* B = L + buf * (6 * 32 * 64);
        for (int i = 0; i < 32; ++i) {
            const LAS float* Bi = B + i * 64 + k0;
            float dec[8], kap[8], kb[8], kp[8], rr[8];
#pragma unroll
            for (int q = 0; q < 2; ++q) { const f32x4 a = *(const LAS f32x4*)(Bi + 0 * 2048 + 4 * q), b = *(const LAS f32x4*)(Bi + 1 * 2048 + 4 * q), cc = *(const LAS f32x4*)(Bi + 2 * 2048 + 4 * q), d = *(const LAS f32x4*)(Bi + 3 * 2048 + 4 * q), e = *(const LAS f32x4*)(Bi + 4 * 2048 + 4 * q);
#pragma unroll
                for (int j = 0; j < 4; ++j) { dec[4 * q + j] = a[j]; kap[4 * q + j] = b[j]; kb[4 * q + j] = cc[j]; kp[4 * q + j] = d[j]; rr[4 * q + j] = e[j]; } }
            const float vv = B[5 * 2048 + i * 64 + vrow];
            float sa = 0.f;
#pragma unroll
            for (int j = 0; j < 8; ++j) sa -= s[j] * kap[j];
            sa = red8(sa);
            float o = 0.f;
#pragma unroll
            for (int j = 0; j < 8; ++j) { s[j] = s[j] * dec[j] + sa * kb[j] + vv * kp[j]; o += s[j] * rr[j]; }
            o = red8(o);
            if (kq == 0) O[(size_t)(blk * 32 + i) * RW + h * HD + vrow] = o;
        }
        if (blk + 1 < TB / 32) write_block(buf ^ 1);
        __syncthreads();
    }
}

__device__ __forceinline__ void phase_post(const Frame& F, int l) {
    const bf16* P = wsp<bf16>(F, WS_P); const bf16* AA = wsp<bf16>(F, WS_AA); const bf16* GG = wsp<bf16>(F, WS_GG); const float* O = wsp<float>(F, WS_O); bf16* OA = wsp<bf16>(F, WS_OA);
    const float* mu = F.in(2) + (size_t)l * 1792;
    const int c = 8 * F.lane; float ka[8], rk[8], lg[8], lb[8];
    ld8f(F.in(9) + l * RW + c, ka); ld8f(F.in(10) + l * RW + c, rk); ld8f(F.in(11) + l * RW + c, lg); ld8f(F.in(12) + l * RW + c, lb);
    for (int t = F.gw; t < TB; t += F.NGW) {
        float o[8], r[8], k[8], v[8], a[8], g[8]; const bf16* pr = P + (size_t)t * PC;
        ld8f(O + (size_t)t * RW + c, o); shift8(pr, t > 0, c, mu, r); shift8(pr, t > 0, 512 + c, mu, k); shift8(pr, t > 0, 1024 + c, mu, v);
        ld8bf(AA + (size_t)t * RW + c, a); ld8bf(GG + (size_t)t * RW + c, g);
        float s = 0.f;
#pragma unroll
        for (int j = 0; j < 8; ++j) s += o[j];
        const float mean = red8(s) * (1.f / 64.f); float q = 0.f, bon = 0.f;
#pragma unroll
        for (int j = 0; j < 8; ++j) { o[j] -= mean; q += o[j] * o[j]; bon += r[j] * k[j] * (1.f + (a[j] - 1.f) * ka[j]) * rk[j]; }
        const float rstd = 1.f / sqrtf(red8(q) * (1.f / 64.f) + GN_EPS); bon = red8(bon);
        float y[8];
#pragma unroll
        for (int j = 0; j < 8; ++j) y[j] = (o[j] * rstd * lg[j] + lb[j] + bon * v[j]) * g[j];
        st8bf(OA + (size_t)t * RW + c, y);
    }
}

__device__ __forceinline__ void ln_row(float* xrow, bf16* brow, const float* g, const float* b, int lane) {
    f32x4 v[4]; float s = 0.f;
#pragma unroll
    for (int j = 0; j < 4; ++j) { v[j] = *(const f32x4*)(xrow + 4 * lane + 256 * j); s += (v[j][0] + v[j][1]) + (v[j][2] + v[j][3]); }
    const float mean = wave_sum(s) * (1.f / D); float s2 = 0.f;
#pragma unroll
    for (int j = 0; j < 4; ++j) { v[j] = v[j] - mean; s2 += (v[j][0] * v[j][0] + v[j][1] * v[j][1]) + (v[j][2] * v[j][2] + v[j][3] * v[j][3]); }
    const float rstd = 1.f / sqrtf(wave_sum(s2) * (1.f / D) + LN_EPS);
#pragma unroll
    for (int j = 0; j < 4; ++j) { const f32x4 gg = *(const f32x4*)(g + 4 * lane + 256 * j), bb = *(const f32x4*)(b + 4 * lane + 256 * j); const f32x4 y = v[j] * rstd * gg + bb;
        *(f32x4*)(xrow + 4 * lane + 256 * j) = y;
        if (brow) { v2u w; w.x = cvt_pk_bf16(y[0], y[1]); w.y = cvt_pk_bf16(y[2], y[3]); *(v2u*)(brow + 4 * lane + 256 * j) = w; } }
}
__device__ __forceinline__ void phase_ln(const Frame& F, int r0, int nrows, const float* g, const float* b) {
    bf16* xb = wsp<bf16>(F, WS_XB);
    for (int m = F.gw; m < nrows; m += F.NGW) ln_row(F.out + (size_t)(r0 + m) * D, xb + (size_t)(r0 + m) * D, g, b, F.lane);
}

__device__ __forceinline__ void phase_router(const Frame& F) {
    LAS float* WR = (LAS float*)F.lds; LAS unsigned* lcnt = (LAS unsigned*)(F.lds + 32768);
    const float* wr = F.in(27);
    for (int i = F.tid; i < D * NE / 4; i += 512) *(LAS f32x4*)(WR + 4 * i) = *(const f32x4*)(wr + 4 * i);
    if (F.tid < NE) lcnt[F.tid] = 0u;
    __syncthreads();
    int* TOKE = wsp<int>(F, WS_TOKE); f32x2* TOKW = wsp<f32x2>(F, WS_TOKW);
    for (int t = F.gw; t < M; t += F.NGW) {
        const float* xr = F.out + (size_t)t * D; float lg[NE];
#pragma unroll
        for (int e = 0; e < NE; ++e) lg[e] = 0.f;
#pragma unroll
        for (int j = 0; j < 4; ++j) { const f32x4 xv = *(const f32x4*)(xr + 4 * F.lane + 256 * j);
#pragma unroll
            for (int q = 0; q < 4; ++q) { const LAS float* w = WR + (4 * F.lane + 256 * j + q) * NE; const f32x4 w0 = *(const LAS f32x4*)w, w1 = *(const LAS f32x4*)(w + 4);
                lg[0] += xv[q] * w0[0]; lg[1] += xv[q] * w0[1]; lg[2] += xv[q] * w0[2]; lg[3] += xv[q] * w0[3]; lg[4] += xv[q] * w1[0]; lg[5] += xv[q] * w1[1]; lg[6] += xv[q] * w1[2]; lg[7] += xv[q] * w1[3]; } }
#pragma unroll
        for (int e = 0; e < NE; ++e) lg[e] = wave_sum(lg[e]);
        int e1 = 0; float l1 = lg[0];
#pragma unroll
        for (int e = 1; e < NE; ++e) if (lg[e] > l1) { l1 = lg[e]; e1 = e; }
        int e2 = -1; float l2 = -3.0e38f;
#pragma unroll
        for (int e = 0; e < NE; ++e) if (e != e1 && lg[e] > l2) { l2 = lg[e]; e2 = e; }
        const float ex = __expf(l2 - l1), w1 = 1.f / (1.f + ex), w2 = ex * w1;
        if (F.lane == 0) { TOKE[t] = e1 | (e2 << 8); TOKW[t] = (f32x2){w1, w2}; atomicAdd((unsigned*)&lcnt[e1], 1u); atomicAdd((unsigned*)&lcnt[e2], 1u); }
    }
    __syncthreads();
    if (F.tid < NE && lcnt[F.tid]) __hip_atomic_fetch_add(F.ctl + CW_MOE + 64 * F.tid, lcnt[F.tid], RLX_AGENT);
}
__device__ __forceinline__ void phase_assign(const Frame& F) {
    LAS unsigned* lc = (LAS unsigned*)F.lds;
    LAS int* lslot = (LAS int*)(F.lds + 256);
    const int* TOKE = wsp<int>(F, WS_TOKE); int* SLOT = wsp<int>(F, WS_SLOT); int* BLKE = wsp<int>(F, WS_BLKE);
    unsigned cnt[NE], pst[NE]; unsigned acc = 0;
#pragma unroll
    for (int e = 0; e < NE; ++e) { cnt[e] = __hip_atomic_load(F.ctl + CW_MOE + 64 * e, RLX_AGENT); pst[e] = acc; acc += ((cnt[e] + 255u) >> 8) << 8; }
    const int nblk = (int)(acc >> 8);
    if (F.tid < NE) lc[F.tid] = 0u;
    if (F.tid == 0) {
#pragma unroll
        for (int e = 0; e < NE; ++e) lc[16 + e] = pst[e]; }
    __syncthreads();
    if ((int)blockIdx.x + F.z == 0) { for (int i = F.tid; i <= NBLK_MAX; i += 512) { int e = 0;
#pragma unroll
            for (int q = 1; q < NE; ++q) if ((unsigned)(i * 256) >= pst[q]) e = q;
            if (i < NBLK_MAX) BLKE[i] = e; else BLKE[NBLK_MAX] = nblk; } }
    const int tpw = M / F.G;
    const int t0 = F.vcu * tpw;
    int e1 = 0, e2 = 0, r1 = 0, r2 = 0;
    for (int base = 0; base < tpw; base += 512) {
        const int i = base + F.tid;
        if (i < tpw) { const int te = TOKE[t0 + i]; e1 = te & 255; e2 = te >> 8; r1 = (int)atomicAdd((unsigned*)&lc[e1], 1u); r2 = (int)atomicAdd((unsigned*)&lc[e2], 1u); }
    }
    __syncthreads();
    if (F.tid < NE) lc[8 + F.tid] = lc[F.tid] ? __hip_atomic_fetch_add(F.ctl + CW_MOE + 64 * (8 + F.tid), lc[F.tid], RLX_AGENT) : 0u;
    __syncthreads();
    if (F.tid < tpw) { const int s1 = (int)(lc[16 + e1] + lc[8 + e1]) + r1, s2 = (int)(lc[16 + e2] + lc[8 + e2]) + r2; lslot[2 * F.tid] = s1; lslot[2 * F.tid + 1] = s2; SLOT[2 * (t0 + F.tid)] = s1; SLOT[2 * (t0 + F.tid) + 1] = s2; }
    __syncthreads();
    const bf16* xb = wsp<bf16>(F, WS_XB); bf16* XG = wsp<bf16>(F, WS_XG);
    for (int i = F.wave; i < tpw; i += NWAVES) { const v4u* src = (const v4u*)(xb + (size_t)(t0 + i) * D); const v4u a = src[F.lane], b = src[64 + F.lane];
#pragma unroll
        for (int q = 0; q < 2; ++q) { v4u* dst = (v4u*)(XG + (size_t)lslot[2 * i + q] * D); dst[F.lane] = a; dst[64 + F.lane] = b; } }
}
__device__ __forceinline__ void phase_combine(const Frame& F, const float* g, const float* b) {
    const bf16* YD = wsp<bf16>(F, WS_XG); const int* SLOT = wsp<int>(F, WS_SLOT); const f32x2* TOKW = wsp<f32x2>(F, WS_TOKW);
    for (int t = F.gw; t < M; t += F.NGW) {
        float* xrow = F.out + (size_t)t * D; const int s1 = SLOT[2 * t], s2 = SLOT[2 * t + 1]; const f32x2 w = TOKW[t];
        const bf16* y1 = YD + (size_t)s1 * D; const bf16* y2 = YD + (size_t)s2 * D;
#pragma unroll
        for (int j = 0; j < 4; ++j) { const int cidx = 4 * F.lane + 256 * j; f32x4 v = *(const f32x4*)(xrow + cidx); float a[4], c[4]; ld4bf(y1 + cidx, a); ld4bf(y2 + cidx, c);
#pragma unroll
            for (int q = 0; q < 4; ++q) v[q] = v[q] * ALPHA + w[0] * a[q] + w[1] * c[q];
            *(f32x4*)(xrow + cidx) = v; }
        ln_row(xrow, nullptr, g, b, F.lane);
    }
}

struct Args { const float* in[33]; float* out; unsigned char* ws; int ph_lo, ph_hi; };
constexpr int NPH = 1 + 2 * 16 + 3 + (2 + 2 * MOE_NCH + 1);
struct KState { LAS unsigned char* L; unsigned char* ws; float* out; int lo, hi, wave_s; XcdBarrier bar; };
#define PH_ON (K.lo <= pid && pid < K.hi)
#define PH_END do { if (K.lo <= pid && pid + 1 < K.hi) xcd_barrier(K.bar, K.wave_s == 0 && lane_id() == 0); ++pid; } while (0)
#define FRAME() Frame F; mkframe(F, K.L, K.ws, K.out, K.wave_s); LAS unsigned char* ring = F.lds; const int cid = (int)blockIdx.x + F.z; (void)ring; (void)cid

template <int l, int b> __device__ __forceinline__ void mixer_phases(const KState& K, int& pid) {
    if (PH_ON) { FRAME(); const size_t r0 = (size_t)b * TB;
        pg8::Gemm g{wsp<bf16>(F, WS_XB) + r0 * D, wsp<bf16>(F, WS_WIN) + (size_t)l * 6144 * D, TB, 6144, D}; pg8::StaticOrder S; S.init(TB, 6144, F.G, cid);
        pg8::EpiPG E{wsp<bf16>(F, WS_P), wsp<bf16>(F, WS_G)}; pg8::gemm_phase<pg8::EpiPG, pg8::StaticOrder, true, true>(ring, g, S, E, F.tid); }
    PH_END;
    if (PH_ON) { FRAME(); phase_b(F, l); }
    PH_END;
    if (PH_ON) { FRAME(); pg8::Gemm g{wsp<bf16>(F, WS_LA), wsp<bf16>(F, WS_WLORA) + (size_t)l * (MiB / 2), TB, 1536, 256}; pg8::StaticOrder S; S.init(TB, 1536, F.G, cid);
        pg8::EpiLora E{wsp<float>(F, WS_LD), wsp<bf16>(F, WS_AA), (long)((WS_GG - WS_AA) / 2), F.in(3) + l * RW, F.in(5) + l * RW}; pg8::gemm_phase<pg8::EpiLora, pg8::StaticOrder, true, true>(ring, g, S, E, F.tid); }
    PH_END;
    if (PH_ON) { FRAME(); phase_scan_naive(F, l); }
    PH_END;
    if (PH_ON) { FRAME(); phase_post(F, l); }
    PH_END;
    if (PH_ON) { FRAME();
        { pg8::Gemm g{wsp<bf16>(F, WS_OA), wsp<bf16>(F, WS_WOA) + (size_t)l * D * RW, TB, D, RW}; pg8::StaticOrder S; S.init(TB, D, F.G, cid);
          pg8::EpiMerge<0> E{wsp<bf16>(F, WS_G), 0, wsp<float>(F, WS_MRG), wsp<bf16>(F, WS_MRGB)}; pg8::gemm_phase<pg8::EpiMerge<0>, pg8::StaticOrder, true, true>(ring, g, S, E, F.tid); } }
    if (PH_ON) { FRAME();
        { pg8::Gemm g{wsp<bf16>(F, WS_UB), wsp<bf16>(F, WS_WOB) + (size_t)l * D * 256, TB, D, 256}; pg8::StaticOrder S; S.init(TB, D, F.G, cid);
          pg8::EpiMerge<1> E{wsp<bf16>(F, WS_G), 1024, wsp<float>(F, WS_MRG), wsp<bf16>(F, WS_MRGB)}; pg8::gemm_phase<pg8::EpiMerge<1>, pg8::StaticOrder, true, true>(ring, g, S, E, F.tid); } }
    if (PH_ON) { FRAME();
        { pg8::Gemm g{wsp<bf16>(F, WS_UC), wsp<bf16>(F, WS_WOC) + (size_t)l * D * 256, TB, D, 256}; pg8::StaticOrder S; S.init(TB, D, F.G, cid);
          pg8::EpiMerge<2> E{wsp<bf16>(F, WS_G), 2048, wsp<float>(F, WS_MRG), wsp<bf16>(F, WS_MRGB)}; pg8::gemm_phase<pg8::EpiMerge<2>, pg8::StaticOrder, true, true>(ring, g, S, E, F.tid); } }
    PH_END;
    if (PH_ON) { FRAME(); const size_t r0 = (size_t)b * TB;
        pg8::Gemm g{wsp<bf16>(F, WS_MRGB), wsp<bf16>(F, WS_WOUT) + (size_t)l * D * D, TB, D, D}; pg8::StaticOrder S; S.init(TB, D, F.G, cid);
        pg8::EpiResid E{(l == 0 ? F.in(0) : (const float*)F.out) + r0 * D, F.out + r0 * D, ALPHA}; pg8::gemm_phase<pg8::EpiResid, pg8::StaticOrder, true, true>(ring, g, S, E, F.tid); }
    PH_END;
    if (PH_ON) { FRAME(); phase_ln(F, b * TB, TB, F.in(22) + l * D, F.in(23) + l * D); }
    PH_END;
}
template <int ch> __device__ __forceinline__ void moe_chunk_phases(const KState& K, int& pid) {
    if (PH_ON) { FRAME(); const int* BLKE = wsp<int>(F, WS_BLKE); int nb = BLKE[NBLK_MAX] - ch * MOE_CH; nb = nb < 0 ? 0 : (nb > MOE_CH ? MOE_CH : nb);
        if (nb > 0) { pg8::Gemm g{wsp<bf16>(F, WS_XG), wsp<bf16>(F, WS_MOEWGU), nb * 256, 2 * DFF, D}; pg8::MoeOrder S; S.init(nb * 256, 2 * DFF, F.G, cid); S.blk0 = ch * MOE_CH; S.blke = BLKE;
            pg8::EpiSwiglu E{wsp<bf16>(F, WS_HCH) - (size_t)ch * MOE_CH * 256 * DFF, DFF}; pg8::gemm_phase<pg8::EpiSwiglu, pg8::MoeOrder, true, true>(ring, g, S, E, F.tid); } }
    PH_END;
    if (PH_ON) { FRAME(); const int* BLKE = wsp<int>(F, WS_BLKE); int nb = BLKE[NBLK_MAX] - ch * MOE_CH; nb = nb < 0 ? 0 : (nb > MOE_CH ? MOE_CH : nb);
        if (nb > 0) { pg8::Gemm g{wsp<bf16>(F, WS_HCH) - (size_t)ch * MOE_CH * 256 * DFF, wsp<bf16>(F, WS_MOEWD), nb * 256, D, DFF}; pg8::MoeOrder S; S.init(nb * 256, D, F.G, cid); S.blk0 = ch * MOE_CH; S.blke = BLKE;
            pg8::EpiBf16 E{wsp<bf16>(F, WS_XG), D}; pg8::gemm_phase<pg8::EpiBf16, pg8::MoeOrder, true, true>(ring, g, S, E, F.tid); } }
    PH_END;
}
__global__ void __launch_bounds__(NWAVES * 64, 2) fwd(Args args) {
    extern __shared__ __attribute__((aligned(16))) unsigned char lds[];
    KState K;
    K.L = (LAS unsigned char*)lds; K.ws = args.ws; K.out = args.out; K.lo = args.ph_lo; K.hi = args.ph_hi;
    volatile LAS unsigned* MISC = (volatile LAS unsigned*)(K.L + MISC_OFF);
    K.wave_s = __builtin_amdgcn_readfirstlane((int)threadIdx.x >> 6);
    for (int u = K.wave_s * 64 + lane_id(); u < (LDS_BYTES - RING_BYTES) / 4; u += NWAVES * 64) ((LAS unsigned*)(K.L + RING_BYTES))[u] = 0u;
    __syncthreads();
    unsigned* const barw = (unsigned*)(args.ws + WS_CTL) + CW_BAR;
    K.bar.bar = barw; K.bar.x = 0; K.bar.st = nullptr;
    if (K.hi - K.lo > 1) K.bar = xcd_barrier_post(barw, MISC + 8, K.wave_s == 0 && lane_id() == 0);
    int pid = 0;

    if (PH_ON) { FRAME(); p0_prologue(F); }
    PH_END;
    mixer_phases<0, 0>(K, pid);
    mixer_phases<0, 1>(K, pid);
    {
        if (PH_ON) { FRAME(); pg8::Gemm g{wsp<bf16>(F, WS_XB), wsp<bf16>(F, WS_WGU), M, 2 * DFF, D}; pg8::StaticOrder S; S.init(M, 2 * DFF, F.G, cid);
            pg8::EpiSwiglu E{wsp<bf16>(F, WS_H), DFF}; pg8::gemm_phase<pg8::EpiSwiglu, pg8::StaticOrder, true, true>(ring, g, S, E, F.tid); }
        PH_END;
        if (PH_ON) { FRAME(); pg8::Gemm g{wsp<bf16>(F, WS_H), wsp<bf16>(F, WS_WD), M, D, DFF}; pg8::StaticOrder S; S.init(M, D, F.G, cid);
            pg8::EpiResid E{F.out, F.out, ALPHA}; pg8::gemm_phase<pg8::EpiResid, pg8::StaticOrder, true, true>(ring, g, S, E, F.tid); }
        PH_END;
        if (PH_ON) { FRAME(); phase_ln(F, 0, M, F.in(31), F.in(32)); }
        PH_END;
    }
    mixer_phases<1, 0>(K, pid);
    mixer_phases<1, 1>(K, pid);
    {
        if (PH_ON) { FRAME(); moe_weights(F); __syncthreads(); phase_router(F); }
        PH_END;
        if (PH_ON) { FRAME(); phase_assign(F); }
        PH_END;
        moe_chunk_phases<0>(K, pid); moe_chunk_phases<1>(K, pid); moe_chunk_phases<2>(K, pid); moe_chunk_phases<3>(K, pid); moe_chunk_phases<4>(K, pid);
        if (PH_ON) { FRAME(); phase_combine(F, F.in(31) + D, F.in(32) + D); }
        PH_END;
    }
}
#undef PH_ON
#undef PH_END
#undef FRAME

extern "C" void kernel_launch(void* const* d_in, const int* in_sizes, int n_in, void* d_out, int out_size, void* d_ws, size_t ws_size, hipStream_t stream) {
    static int grid = 0;
    if (grid == 0) {
        if (n_in != 33 || in_sizes[0] != M * D || out_size != M * D || ws_size < WS_END) { fprintf(stderr, "kernel_launch: unexpected shapes / workspace (n_in %d, ws %zu)\n", n_in, ws_size); grid = -1; return; }
        int dev = 0, cus = 0, per_cu = 0;
        if (hipGetDevice(&dev) != hipSuccess || hipDeviceGetAttribute(&cus, hipDeviceAttributeMultiprocessorCount, dev) != hipSuccess) { grid = -1; return; }
        if (hipFuncSetAttribute((const void*)fwd, hipFuncAttributeMaxDynamicSharedMemorySize, LDS_BYTES) != hipSuccess) { fprintf(stderr, "kernel_launch: hipFuncSetAttribute failed\n"); grid = -1; return; }
        if (hipOccupancyMaxActiveBlocksPerMultiprocessor(&per_cu, (const void*)fwd, NWAVES * 64, LDS_BYTES) != hipSuccess || per_cu < 1) fprintf(stderr, "kernel_launch: occupancy query reports %d\n", per_cu);
        (void)hipGetLastError();
        grid = cus;
    }
    if (grid < 0) return;
    if (hipMemsetAsync((char*)d_ws + WS_CTL, 0, CTL_ZERO_BYTES, stream) != hipSuccess) return;
    Args a{};
    for (int i = 0; i < 33; ++i) a.in[i] = (const float*)d_in[i];
    a.out = (float*)d_out; a.ws = (unsigned char*)d_ws;
#if MK_ONE_LAUNCH
    a.ph_lo = 0; a.ph_hi = NPH;
    hipLaunchKernelGGL(fwd, dim3(grid), dim3(NWAVES * 64), LDS_BYTES, stream, a);
#else
    for (int p = 0; p < NPH; ++p) { a.ph_lo = p; a.ph_hi = p + 1; hipLaunchKernelGGL(fwd, dim3(grid), dim3(NWAVES * 64), LDS_BYTES, stream, a); }
#endif
}
```

```cpp
#include <hip/hip_runtime.h>
#include <cstdio>
#include <cstdint>
namespace pg8 {
#define PG8_LAS __attribute__((address_space(3)))
typedef unsigned short bf16_t;
typedef short bf16x8 __attribute__((ext_vector_type(8)));
typedef float f32x4 __attribute__((ext_vector_type(4)));
typedef unsigned u32x4 __attribute__((ext_vector_type(4)));
typedef unsigned u32x2 __attribute__((ext_vector_type(2)));
constexpr int BM = 256, BK = 64, HALF = 128, HTB = HALF * BK * 2  , STAGE_BYTES = 8 * HTB, NXCD = 8, WGM = 8;

__host__ __device__ __forceinline__ int lds_byte(int r, int c) { const int st = (r >> 4) * 2 + (c >> 5), rr = r & 15, cc = c & 31, ob = rr * 64 + cc * 2; return st * 1024 + (ob ^ (((ob >> 9) & 1) << 5)); }
__host__ __device__ __forceinline__ void stage_rc(int b, int& R, int& C) { const int st = b / 1024, sb = b % 1024, swz = sb ^ (((sb >> 9) & 1) << 5); R = (st >> 1) * 16 + swz / 64; C = (st & 1) * 32 + (swz % 64) / 2; }
__host__ __device__ __forceinline__ int perm32(int rho) { const int n = rho >> 4, i = rho & 15; return 8 * (i >> 2) + 4 * n + (i & 3); }

struct Unit { int pm, pn, pb; };
struct Gemm { const bf16_t* A; const bf16_t* Bt; int M, N, K; };

struct StaticOrder {
    int nM, nN, nwg, G, c;
    __host__ __device__ void init(int M, int N, int G_, int c_) { nM = M / BM; nN = N / BM; nwg = nM * nN; G = G_; c = c_; }
    __host__ __device__ bool next(int i, Unit& u) const {
        const long L = (long)i * G + c; if (L >= nwg) return false;
        int wgid = (int)L; { const int q = nwg / NXCD, r = nwg % NXCD, xcd = wgid % NXCD, off = wgid / NXCD; wgid = (xcd < r ? xcd * (q + 1) : r * (q + 1) + (xcd - r) * q) + off; }
        const int nig = WGM * nN, gid = wgid / nig, fm = gid * WGM, gsz = (nM - fm) < WGM ? (nM - fm) : WGM;
        u.pm = fm + ((wgid % nig) % gsz); u.pn = (wgid % nig) / gsz; u.pb = u.pn; return true;
    }
    __device__ __forceinline__ void a_ready(const Unit&) const {}
    __device__ __forceinline__ void done(const Unit&) const {}
};
struct MoeOrder : StaticOrder {
    int blk0; const int* blke;
    __device__ __forceinline__ bool next(int i, Unit& u) const {
        if (!StaticOrder::next(i, u)) return false;
        u.pm += blk0; u.pb = blke[u.pm] * nN + u.pn; return true;
    }
};

typedef __bf16 bf16x2_t __attribute__((ext_vector_type(2)));
typedef float f32x2_t __attribute__((ext_vector_type(2)));
__device__ __forceinline__ unsigned cvt_pk_bf16(float lo, float hi) { const f32x2_t v = {lo, hi}; const bf16x2_t b = __builtin_convertvector(v, bf16x2_t); return __builtin_bit_cast(unsigned, b); }
__device__ __forceinline__ float sigm(float x) { return __builtin_amdgcn_rcpf(1.f + __builtin_amdgcn_exp2f(-1.44269504f * x)); }
__device__ __forceinline__ float bflo(unsigned w) { return __uint_as_float(w << 16); }
__device__ __forceinline__ float bfhi(unsigned w) { return __uint_as_float(w & 0xffff0000u); }

#define PG8_ROWS(ai, m) for (int ai = 0; ai < 2; ++ai) _Pragma("unroll") for (int m = 0; m < 4; ++m)

struct EpiBf16 {
    static constexpr bool PERM = true, AFTER_DRAIN = false;
    bf16_t* O; int ldc;
    __device__ __forceinline__ void operator()(const f32x4 (&acc)[2][2][4][2], const Unit& u, int wr, int wc, int fr, int fq) const {
        const int row0 = u.pm * BM + wr * 64 + fr, col0 = u.pn * BM + wc * 32 + 8 * fq;
#pragma unroll
        PG8_ROWS(ai, m) { bf16_t* rowp = O + (size_t)(row0 + ai * HALF + m * 16) * ldc + col0;
#pragma unroll
            for (int bj = 0; bj < 2; ++bj) { const f32x4 v0 = acc[ai][bj][m][0], v1 = acc[ai][bj][m][1];
                u32x4 w; w.x = cvt_pk_bf16(v0[0], v0[1]); w.y = cvt_pk_bf16(v0[2], v0[3]); w.z = cvt_pk_bf16(v1[0], v1[1]); w.w = cvt_pk_bf16(v1[2], v1[3]);
                *(u32x4*)(rowp + bj * HALF) = w; } }
    }
};
struct EpiPG {
    static constexpr bool PERM = true, AFTER_DRAIN = false;
    bf16_t* P; bf16_t* G;
    __device__ __forceinline__ void operator()(const f32x4 (&acc)[2][2][4][2], const Unit& u, int wr, int wc, int fr, int fq) const {
        const int row0 = u.pm * BM + wr * 64 + fr; int colt = u.pn * BM; const bool isg = colt >= 3072; bf16_t* base = isg ? G : P; if (isg) colt -= 3072;
        const int col0 = colt + wc * 32 + 8 * fq;
#pragma unroll
        PG8_ROWS(ai, m) { bf16_t* rowp = base + (size_t)(row0 + ai * HALF + m * 16) * 3072 + col0;
#pragma unroll
            for (int bj = 0; bj < 2; ++bj) { f32x4 v0 = acc[ai][bj][m][0], v1 = acc[ai][bj][m][1];
                if (isg) {
#pragma unroll
                    for (int j = 0; j < 4; ++j) { v0[j] = sigm(v0[j]); v1[j] = sigm(v1[j]); } }
                u32x4 w; w.x = cvt_pk_bf16(v0[0], v0[1]); w.y = cvt_pk_bf16(v0[2], v0[3]); w.z = cvt_pk_bf16(v1[0], v1[1]); w.w = cvt_pk_bf16(v1[2], v1[3]);
                *(u32x4*)(rowp + bj * HALF) = w; } }
    }
};
struct EpiLora {
    static constexpr bool PERM = true, AFTER_DRAIN = false;
    float* LD; bf16_t* AA; long gg_off; const float* w0; const float* a0;
    __device__ __forceinline__ void operator()(const f32x4 (&acc)[2][2][4][2], const Unit& u, int wr, int wc, int fr, int fq) const {
        const int row0 = u.pm * BM + wr * 64 + fr; const int kind = u.pn >> 1; const int col0 = (u.pn & 1) * BM + wc * 32 + 8 * fq;
        const float* bias = (kind == 0 ? w0 : a0) + col0; const float bs = kind == 2 ? 0.f : 1.f;
#pragma unroll
        PG8_ROWS(ai, m) { const size_t ro = (size_t)(row0 + ai * HALF + m * 16) * 512 + col0;
#pragma unroll
            for (int bj = 0; bj < 2; ++bj) { f32x4 v0 = acc[ai][bj][m][0] + *(const f32x4*)(bias + bj * HALF) * bs, v1 = acc[ai][bj][m][1] + *(const f32x4*)(bias + bj * HALF + 4) * bs;
                if (kind == 0) {
#pragma unroll
                    for (int j = 0; j < 4; ++j) {
                        { const float y = -v0[j]; const float sp = fmaxf(y, 0.f) + __logf(1.f + __expf(-fabsf(y))); v0[j] = -__expf(-sp - 0.5f); }
                        { const float y = -v1[j]; const float sp = fmaxf(y, 0.f) + __logf(1.f + __expf(-fabsf(y))); v1[j] = -__expf(-sp - 0.5f); } }
                    *(f32x4*)(LD + ro + bj * HALF) = v0; *(f32x4*)(LD + ro + bj * HALF + 4) = v1;
                } else {
                    if (kind == 1) {
#pragma unroll
                        for (int j = 0; j < 4; ++j) { v0[j] = sigm(v0[j]); v1[j] = sigm(v1[j]); } }
                    u32x4 w; w.x = cvt_pk_bf16(v0[0], v0[1]); w.y = cvt_pk_bf16(v0[2], v0[3]); w.z = cvt_pk_bf16(v1[0], v1[1]); w.w = cvt_pk_bf16(v1[2], v1[3]);
                    *(u32x4*)(AA + (kind == 1 ? 0l : gg_off) + ro + bj * HALF) = w; } }
            asm volatile("" ::: "memory"); }
    }
};
template <int MODE> struct EpiMerge {
    static constexpr bool PERM = true, AFTER_DRAIN = false;
    const bf16_t* G; int gcol0; float* MRG; bf16_t* MRGB;
    __device__ __forceinline__ void operator()(const f32x4 (&acc)[2][2][4][2], const Unit& u, int wr, int wc, int fr, int fq) const {
        const int row0 = u.pm * BM + wr * 64 + fr, col0 = u.pn * BM + wc * 32 + 8 * fq;
#pragma unroll
        PG8_ROWS(ai, m) { const size_t row = (size_t)(row0 + ai * HALF + m * 16);
#pragma unroll
            for (int bj = 0; bj < 2; ++bj) { const int col = col0 + bj * HALF;
                const u32x4 gw = *(const u32x4*)(G + row * 3072 + gcol0 + col);
                f32x4 v0 = acc[ai][bj][m][0], v1 = acc[ai][bj][m][1];
                v0[0] *= bflo(gw.x); v0[1] *= bfhi(gw.x); v0[2] *= bflo(gw.y); v0[3] *= bfhi(gw.y); v1[0] *= bflo(gw.z); v1[1] *= bfhi(gw.z); v1[2] *= bflo(gw.w); v1[3] *= bfhi(gw.w);
                float* mp = MRG + row * 1024 + col;
                if (MODE >= 1) { v0 += *(const f32x4*)mp; v1 += *(const f32x4*)(mp + 4); }
                if (MODE <= 1) { *(f32x4*)mp = v0; *(f32x4*)(mp + 4) = v1; }
                else { u32x4 w; w.x = cvt_pk_bf16(v0[0], v0[1]); w.y = cvt_pk_bf16(v0[2], v0[3]); w.z = cvt_pk_bf16(v1[0], v1[1]); w.w = cvt_pk_bf16(v1[2], v1[3]); *(u32x4*)(MRGB + row * 1024 + col) = w; } } }
    }
};
struct EpiResid {
    static constexpr bool PERM = false, AFTER_DRAIN = false;
    const float* src; float* out; float alpha;
    __device__ __forceinline__ void operator()(const f32x4 (&acc)[2][2][4][2], const Unit& u, int wr, int wc, int fr, int fq) const {
        const int row0 = u.pm * BM + wr * 64 + fr, col0 = u.pn * BM + wc * 32 + 4 * fq;
#pragma unroll
        PG8_ROWS(ai, m) { const size_t off = (size_t)(row0 + ai * HALF + m * 16) * 1024 + col0;
#pragma unroll
            for (int bj = 0; bj < 2; ++bj)
#pragma unroll
                for (int n = 0; n < 2; ++n) { const f32x4 s = *(const f32x4*)(src + off + bj * HALF + n * 16); *(f32x4*)(out + off + bj * HALF + n * 16) = s * alpha + acc[ai][bj][m][n]; } }
    }
};
struct EpiSwiglu {
    static constexpr bool PERM = true, AFTER_DRAIN = false;
    bf16_t* H; int ldc;
    __device__ __forceinline__ void operator()(const f32x4 (&acc)[2][2][4][2], const Unit& u, int wr, int wc, int fr, int fq) const {
        const int row0 = u.pm * BM + wr * 64 + fr, col0 = u.pn * HALF + wc * 32 + 8 * fq;
#pragma unroll
        PG8_ROWS(ai, m) { bf16_t* rowp = H + (size_t)(row0 + ai * HALF + m * 16) * ldc + col0;
            f32x4 v0 = acc[ai][0][m][0], v1 = acc[ai][0][m][1]; const f32x4 u0 = acc[ai][1][m][0], u1 = acc[ai][1][m][1];
#pragma unroll
            for (int j = 0; j < 4; ++j) { v0[j] = v0[j] * sigm(v0[j]) * u0[j]; v1[j] = v1[j] * sigm(v1[j]) * u1[j]; }
            u32x4 w; w.x = cvt_pk_bf16(v0[0], v0[1]); w.y = cvt_pk_bf16(v0[2], v0[3]); w.z = cvt_pk_bf16(v1[0], v1[1]); w.w = cvt_pk_bf16(v1[2], v1[3]);
            *(u32x4*)rowp = w; }
    }
};
template <class Epi, class Sched, bool ALIGN_EPI = false, bool SP2 = false>
__device__ __forceinline__ void gemm_phase(PG8_LAS unsigned char* lds, const Gemm g, const Sched& S, const Epi& E, const int tid) {
    const int wid = __builtin_amdgcn_readfirstlane(tid >> 6), lane = tid & 63, wr = wid >> 2, wc = wid & 3, fr = lane & 15, fq = lane >> 4;
    const int K = g.K, nt = K / BK;
    unsigned voffA[2], voffB[2];
#pragma unroll
    for (int i = 0; i < 2; ++i) { int R, C; stage_rc(tid * 16 + i * 8192, R, C); const int Rb = Epi::PERM ? ((R & ~31) + perm32(R & 31)) : R;
        voffA[i] = (unsigned)(R * K + C) * 2u; voffB[i] = (unsigned)(Rb * K + C) * 2u; }
    const size_t kstep = (size_t)(BK * 2);
    const size_t hstep = (size_t)HALF * K * 2;
    const size_t tstep = 2 * hstep;
    const unsigned ldsw = (unsigned)wid * 1024u;
    const int aoff = lds_byte(wr * 64 + fr, fq * 8), boff = lds_byte(wc * 32 + fr, fq * 8);
#define PG8_SA(b, h) (((b) * 2 + (h)) * HTB)
#define PG8_SB(b, h) ((4 + (b) * 2 + (h)) * HTB)
#define PG8_STAGE(bufoff, gbase, voff) do { _Pragma("unroll") for (int _i = 0; _i < 2; ++_i) \
        __builtin_amdgcn_global_load_lds((const unsigned*)((const char*)(gbase) + (voff)[_i]), (PG8_LAS unsigned*)(lds + (bufoff) + ldsw + _i * 8192), 16, 0, 0); } while (0)
#define PG8_LDA(dst, b, h) do { _Pragma("unroll") for (int m = 0; m < 4; ++m) _Pragma("unroll") for (int k = 0; k < 2; ++k) dst[m][k] = *(const PG8_LAS bf16x8*)(lds + PG8_SA(b, h) + aoff + m * 2048 + k * 1024); } while (0)
#define PG8_LDB(dst, b, h) do { _Pragma("unroll") for (int n = 0; n < 2; ++n) _Pragma("unroll") for (int k = 0; k < 2; ++k) dst[n][k] = *(const PG8_LAS bf16x8*)(lds + PG8_SB(b, h) + boff + n * 2048 + k * 1024); } while (0)
#define PG8_MMA(ai, bj, At, Bt) do { __builtin_amdgcn_s_setprio(1); _Pragma("unroll") for (int m = 0; m < 4; ++m) _Pragma("unroll") for (int n = 0; n < 2; ++n) _Pragma("unroll") for (int k = 0; k < 2; ++k) \
        acc[ai][bj][m][n] = __builtin_amdgcn_mfma_f32_16x16x32_bf16(Bt[n][k], At[m][k], acc[ai][bj][m][n], 0, 0, 0); __builtin_amdgcn_s_setprio(0); } while (0)
#define PG8_WAIT_V(n) asm volatile("s_waitcnt vmcnt(" #n ")" ::: "memory")
#define PG8_WAIT_L(n) asm volatile("s_waitcnt lgkmcnt(" #n ")" ::: "memory")
#define PG8_BAR __builtin_amdgcn_s_barrier()
#define PG8_SCHED __builtin_amdgcn_sched_barrier(0)
    Unit cur, nxt; int ui = 0;
    if (!S.next(0, cur)) return;
    f32x4 acc[2][2][4][2];
#pragma unroll
    for (int a = 0; a < 2; ++a)
#pragma unroll
        for (int b = 0; b < 2; ++b)
#pragma unroll
            for (int m = 0; m < 4; ++m)
#pragma unroll
                for (int n = 0; n < 2; ++n) acc[a][b][m][n] = (f32x4){0.f, 0.f, 0.f, 0.f};
    bf16x8 At[4][2], B0[2][2], B1[2][2];
    const char* cA = (const char*)g.A + (size_t)cur.pm * tstep; const char* cB = (const char*)g.Bt + (size_t)cur.pb * tstep;
    S.a_ready(cur);
    if constexpr (SP2) {
        PG8_STAGE(PG8_SB(0, 0), cB, voffB); PG8_STAGE(PG8_SB(0, 1), cB + hstep, voffB); PG8_STAGE(PG8_SA(0, 0), cA, voffA); PG8_STAGE(PG8_SA(0, 1), cA + hstep, voffA);
        if (wr == 1) PG8_BAR;
        PG8_WAIT_V(2); PG8_BAR;
        PG8_STAGE(PG8_SB(1, 0), cB + kstep, voffB); PG8_STAGE(PG8_SA(1, 0), cA + kstep, voffA); PG8_STAGE(PG8_SB(1, 1), cB + hstep + kstep, voffB);
        PG8_WAIT_V(6); PG8_BAR;
    } else {
        PG8_STAGE(PG8_SB(0, 0), cB, voffB); PG8_STAGE(PG8_SA(0, 0), cA, voffA); PG8_STAGE(PG8_SB(0, 1), cB + hstep, voffB); PG8_STAGE(PG8_SA(0, 1), cA + hstep, voffA);
        if (wr == 1) PG8_BAR;
        PG8_WAIT_V(4); PG8_BAR;
        PG8_STAGE(PG8_SB(1, 0), cB + kstep, voffB); PG8_STAGE(PG8_SA(1, 0), cA + kstep, voffA); PG8_STAGE(PG8_SB(1, 1), cB + hstep + kstep, voffB);
        PG8_WAIT_V(6); PG8_BAR;
    }
    for (;;) {
        const bool has_next = S.next(ui + 1, nxt);
        const char* nA = has_next ? (const char*)g.A + (size_t)nxt.pm * tstep : cA; const char* nB = has_next ? (const char*)g.Bt + (size_t)nxt.pb * tstep : cB;
        for (int t = 0; t < nt; t += 2) {
            const bool last = (t == nt - 2);
            const char* a1 = cA + (size_t)(t + 1) * kstep;
            const char* a2 = last ? nA : cA + (size_t)(t + 2) * kstep; const char* b2 = last ? nB : cB + (size_t)(t + 2) * kstep;
            const char* a3 = a2 + kstep; const char* b3 = b2 + kstep;
            if (last && has_next) S.a_ready(nxt);
            if constexpr (SP2) {
            PG8_LDB(B0, 0, 0); PG8_LDB(B1, 0, 1); PG8_SCHED; PG8_LDA(At, 0, 0); PG8_STAGE(PG8_SA(1, 1), a1 + hstep, voffA);
            PG8_WAIT_V(8); PG8_WAIT_L(0); PG8_BAR; PG8_MMA(0, 0, At, B0); PG8_MMA(0, 1, At, B1); PG8_BAR; PG8_SCHED;
            PG8_LDA(At, 0, 1); PG8_STAGE(PG8_SB(0, 0), b2, voffB); PG8_STAGE(PG8_SB(0, 1), b2 + hstep, voffB); PG8_STAGE(PG8_SA(0, 0), a2, voffA);
            PG8_WAIT_V(8); PG8_WAIT_L(0); PG8_BAR; PG8_MMA(1, 0, At, B0); PG8_MMA(1, 1, At, B1); PG8_BAR; PG8_SCHED;
            PG8_LDB(B0, 1, 0); PG8_LDB(B1, 1, 1); PG8_SCHED; PG8_LDA(At, 1, 0); PG8_STAGE(PG8_SA(0, 1), a2 + hstep, voffA);
            PG8_WAIT_V(8); PG8_WAIT_L(0); PG8_BAR; PG8_MMA(0, 0, At, B0); PG8_MMA(0, 1, At, B1); PG8_BAR; PG8_SCHED;
            PG8_LDA(At, 1, 1); PG8_STAGE(PG8_SB(1, 0), b3, voffB); PG8_STAGE(PG8_SB(1, 1), b3 + hstep, voffB); PG8_STAGE(PG8_SA(1, 0), a3, voffA);
            PG8_WAIT_V(8); PG8_WAIT_L(0); PG8_BAR; PG8_MMA(1, 0, At, B0); PG8_MMA(1, 1, At, B1); PG8_BAR; PG8_SCHED;
            } else {
            PG8_LDB(B0, 0, 0); PG8_SCHED; PG8_LDA(At, 0, 0); PG8_STAGE(PG8_SA(1, 1), a1 + hstep, voffA);
            PG8_WAIT_L(8); PG8_BAR; PG8_WAIT_L(0); PG8_MMA(0, 0, At, B0); PG8_BAR; PG8_SCHED;
            PG8_LDB(B1, 0, 1); PG8_STAGE(PG8_SB(0, 0), b2, voffB);
            PG8_BAR; PG8_WAIT_L(0); PG8_MMA(0, 1, At, B1); PG8_BAR;
            PG8_LDA(At, 0, 1); PG8_STAGE(PG8_SA(0, 0), a2, voffA);
            PG8_BAR; PG8_WAIT_L(0); PG8_MMA(1, 0, At, B0); PG8_BAR; PG8_SCHED;
            PG8_STAGE(PG8_SB(0, 1), b2 + hstep, voffB);
            PG8_WAIT_V(6); PG8_BAR; PG8_MMA(1, 1, At, B1); PG8_BAR;
            PG8_LDB(B0, 1, 0); PG8_SCHED; PG8_LDA(At, 1, 0); PG8_STAGE(PG8_SA(0, 1), a2 + hstep, voffA);
            PG8_WAIT_L(8); PG8_BAR; PG8_WAIT_L(0); PG8_MMA(0, 0, At, B0); PG8_BAR; PG8_SCHED;
            PG8_LDB(B1, 1, 1); PG8_STAGE(PG8_SB(1, 0), b3, voffB);
            PG8_BAR; PG8_WAIT_L(0); PG8_MMA(0, 1, At, B1); PG8_BAR;
            PG8_LDA(At, 1, 1); PG8_STAGE(PG8_SA(1, 0), a3, voffA);
            PG8_BAR; PG8_WAIT_L(0); PG8_MMA(1, 0, At, B0); PG8_BAR; PG8_SCHED;
            PG8_STAGE(PG8_SB(1, 1), b3 + hstep, voffB);
            PG8_WAIT_V(6); PG8_BAR; PG8_MMA(1, 1, At, B1); PG8_BAR;
            }
        }
        if constexpr (ALIGN_EPI) { if (wr == 0) PG8_BAR; }
        if constexpr (!Epi::AFTER_DRAIN) { E(acc, cur, wr, wc, fr, fq); S.done(cur); }
        if (!has_next) break;
#pragma unroll
        for (int a = 0; a < 2; ++a)
#pragma unroll
            for (int b = 0; b < 2; ++b)
#pragma unroll
                for (int m = 0; m < 4; ++m)
#pragma unroll
                    for (int n = 0; n < 2; ++n) acc[a][b][m][n] = (f32x4){0.f, 0.f, 0.f, 0.f};
        cur = nxt; cA = nA; cB = nB; ++ui;
        if constexpr (ALIGN_EPI) { if (wr == 1) PG8_BAR; }
    }
    PG8_WAIT_V(0);
    if constexpr (!ALIGN_EPI) { if (wr == 0) PG8_BAR; }
    PG8_BAR;
    if constexpr (Epi::AFTER_DRAIN) { E.fused(acc, cur, wr, wc, fr, fq, lds, wid, lane); S.done(cur); }
#undef PG8_SA
#undef PG8_SB
#undef PG8_STAGE
#undef PG8_LDA
#undef PG8_LDB
#undef PG8_MMA
#undef PG8_WAIT_V
#undef PG8_WAIT_L
#undef PG8_BAR
#undef PG8_SCHED
}
}

#ifndef MK_ONE_LAUNCH
#define MK_ONE_LAUNCH 1
#endif
constexpr int NWAVES = 8;
constexpr int BATCH = 2, SEQ = 16384, D = 1024, M = BATCH * SEQ, TB = SEQ;
constexpr int RW = 512, NH = 8, HD = 64, PC = 3072, DFF = 2816, NE = 8, NBLK_MAX = 264, MOE_CH = 64, MOE_NCH = 5;
constexpr float LN_EPS = 1e-5f, GN_EPS = 64e-5f, ALPHA = 1.41421356237f;
constexpr size_t MiB = 1u << 20;
constexpr size_t WS_CTL = 0, CTL_ZERO_BYTES = 1 * MiB;
constexpr size_t WS_WIN = 1 * MiB, WS_WOUT = 25 * MiB, WS_WOA = 29 * MiB, WS_WOB = 31 * MiB, WS_WOC = 32 * MiB, WS_WLORA = 33 * MiB, WS_WGU = 35 * MiB, WS_WD = 46 * MiB;
constexpr size_t WS_XB = 52 * MiB, WS_ACT = 116 * MiB;
constexpr size_t WS_P = WS_ACT, WS_G = 212 * MiB, WS_LA = 308 * MiB, WS_LD = 316 * MiB, WS_AA = 348 * MiB, WS_GG = 364 * MiB, WS_O = 380 * MiB, WS_OA = 412 * MiB, WS_UB = 428 * MiB, WS_UC = 436 * MiB;
constexpr size_t WS_MC = 444 * MiB, WS_QE = 460 * MiB, WS_NC = 476 * MiB, WS_S0 = WS_LD;
constexpr size_t WS_MRG = WS_ACT, WS_MRGB = 180 * MiB;
constexpr size_t WS_H = WS_ACT;
constexpr size_t WS_MOEWGU = WS_ACT, WS_MOEWD = 204 * MiB, WS_XG = 248 * MiB, WS_HCH = 380 * MiB, WS_TOKE = 470 * MiB, WS_TOKW = 471 * MiB, WS_SLOT = 472 * MiB, WS_BLKE = 473 * MiB;
constexpr size_t WS_END = 508 * MiB;
constexpr int CW_TMO = 0, CW_BAR = 4096, CW_MOE = 16384;
constexpr int RING_BYTES = 131072, MISC_OFF = RING_BYTES + 320, LDS_BYTES = 147456;

#define GAS __attribute__((address_space(1)))
#define LAS __attribute__((address_space(3)))
typedef unsigned short bf16;
typedef unsigned v4u __attribute__((ext_vector_type(4)));
typedef unsigned v2u __attribute__((ext_vector_type(2)));
typedef float f32x4 __attribute__((ext_vector_type(4)));
typedef float f32x2 __attribute__((ext_vector_type(2)));
#define RLX_AGENT __ATOMIC_RELAXED, __HIP_MEMORY_SCOPE_AGENT
#define LDS_WAIT() asm volatile("s_waitcnt lgkmcnt(0)" ::: "memory")
using pg8::bflo; using pg8::bfhi; using pg8::sigm; using pg8::cvt_pk_bf16;

#define XB_TMO      128
#define XB_XCNT(j)  (256  + 64 * (j))
#define XB_XSUB(j)  (1280 + 64 * (j))
#define XB_XGEN(j)  (2304 + 64 * (j))
#define XB_TOP      3328
#define XB_TOPGEN   3392
#define XCD_BAR_WORDS 3456
#define XB_SPIN_CAP (1u << 18)
__device__ __forceinline__ unsigned xb_ld(unsigned* p)              { return __hip_atomic_load(p, __ATOMIC_RELAXED, __HIP_MEMORY_SCOPE_AGENT); }
__device__ __forceinline__ unsigned xb_add(unsigned* p, unsigned v) { return __hip_atomic_fetch_add(p, v, __ATOMIC_RELAXED, __HIP_MEMORY_SCOPE_AGENT); }
__device__ __forceinline__ unsigned xb_xcc_id() { return (unsigned)__builtin_amdgcn_s_getreg((3 << 11) | 20) & 0xFu; }
#define XB_SPIN(cond, bar) do { unsigned _sp = 0; while (cond) { __builtin_amdgcn_s_sleep(1); \
    if ((++_sp & 255u) == 0u) { if (xb_ld(&(bar)[XB_TMO])) break; if (_sp > XB_SPIN_CAP) { atomicAdd(&(bar)[XB_TMO], 1u); break; } } } } while (0)
struct XcdBarrier { unsigned* bar; unsigned x; volatile LAS unsigned* st; };
__device__ __forceinline__ XcdBarrier xcd_barrier_post(unsigned* bar, volatile LAS unsigned* st, bool leader) {
    XcdBarrier b; b.bar = bar; b.x = xb_xcc_id(); b.st = st;
    if (leader) (void)xb_add(&bar[XB_XCNT(b.x)], 1u);
    return b;
}
__device__ __forceinline__ void xcd_barrier_complete(unsigned* bar, unsigned x, unsigned& nloc, unsigned& nx) {
    const unsigned G = gridDim.x * gridDim.y * gridDim.z;
    unsigned sum, cnt, mine, sp = 0u;
    for (;;) {
        sum = 0u; cnt = 0u; mine = 0u;
#pragma unroll
        for (unsigned j = 0; j < 16; ++j) { const unsigned c = xb_ld(&bar[XB_XCNT(j)]); sum += c; cnt += (c > 0u) ? 1u : 0u; mine = (j == x) ? c : mine; }
        if (sum == G) break;
        __builtin_amdgcn_s_sleep(1);
        if ((++sp & 255u) == 0u) { if (xb_ld(&bar[XB_TMO])) break; if (sp > XB_SPIN_CAP) { atomicAdd(&bar[XB_TMO], 1u); break; } }
    }
    nloc = mine > 0u ? mine : 1u; nx = cnt > 0u ? cnt : 1u;
}
__device__ __forceinline__ void xcd_barrier(const XcdBarrier& b, bool leader) {
    asm volatile("s_waitcnt vmcnt(0)" ::: "memory");
    __syncthreads();
    if (leader) {
        unsigned* bar = b.bar;
        __builtin_amdgcn_s_waitcnt(0);
        unsigned nloc = b.st[0], nx = b.st[1];
        if (nloc == 0u) { xcd_barrier_complete(bar, b.x, nloc, nx); b.st[0] = nloc; b.st[1] = nx; }
        const unsigned old = xb_add(&bar[XB_XSUB(b.x)], 1u);
        const unsigned gen = old / nloc;
        if (old + 1u == (gen + 1u) * nloc) {
            __builtin_amdgcn_fence(__ATOMIC_RELEASE, "agent");
            asm volatile("s_waitcnt vmcnt(0)" ::: "memory");
            const unsigned og = xb_add(&bar[XB_TOP], 1u);
            const unsigned tg = og / nx;
            if (og + 1u == (tg + 1u) * nx) xb_add(&bar[XB_TOPGEN], 1u);
            else XB_SPIN(xb_ld(&bar[XB_TOPGEN]) == tg, bar);
            __builtin_amdgcn_fence(__ATOMIC_ACQUIRE, "agent");
            xb_add(&bar[XB_XGEN(b.x)], 1u);
            asm volatile("s_waitcnt vmcnt(0)" ::: "memory");
        } else {
            XB_SPIN(xb_ld(&bar[XB_XGEN(b.x)]) == gen, bar);
            __builtin_amdgcn_fence(__ATOMIC_ACQUIRE, "agent");
            asm volatile("s_waitcnt vmcnt(0)" ::: "memory");
        }
    }
    __syncthreads();
}

__device__ __forceinline__ float wave_sum(float v) {
#pragma unroll
    for (int o = 1; o < 64; o <<= 1) v += __shfl_xor(v, o);
    return v;
}
__device__ __forceinline__ float red8(float v) { v += __shfl_xor(v, 1); v += __shfl_xor(v, 2); v += __shfl_xor(v, 4); return v; }
__device__ __forceinline__ void ld8bf(const bf16* p, float (&o)[8]) { const v4u w = *(const v4u*)p; o[0] = bflo(w.x); o[1] = bfhi(w.x); o[2] = bflo(w.y); o[3] = bfhi(w.y); o[4] = bflo(w.z); o[5] = bfhi(w.z); o[6] = bflo(w.w); o[7] = bfhi(w.w); }
__device__ __forceinline__ void ld4bf(const bf16* p, float (&o)[4]) { const v2u w = *(const v2u*)p; o[0] = bflo(w.x); o[1] = bfhi(w.x); o[2] = bflo(w.y); o[3] = bfhi(w.y); }
__device__ __forceinline__ void ld8f(const float* p, float (&o)[8]) { const f32x4 a = *(const f32x4*)p, b = *(const f32x4*)(p + 4); o[0] = a[0]; o[1] = a[1]; o[2] = a[2]; o[3] = a[3]; o[4] = b[0]; o[5] = b[1]; o[6] = b[2]; o[7] = b[3]; }
__device__ __forceinline__ void ld4f(const float* p, float (&o)[4]) { const f32x4 a = *(const f32x4*)p; o[0] = a[0]; o[1] = a[1]; o[2] = a[2]; o[3] = a[3]; }
__device__ __forceinline__ void st8bf(bf16* p, const float (&v)[8]) { v4u w; w.x = cvt_pk_bf16(v[0], v[1]); w.y = cvt_pk_bf16(v[2], v[3]); w.z = cvt_pk_bf16(v[4], v[5]); w.w = cvt_pk_bf16(v[6], v[7]); *(v4u*)p = w; }
__device__ __forceinline__ void st4bf(bf16* p, const float (&v)[4]) { v2u w; w.x = cvt_pk_bf16(v[0], v[1]); w.y = cvt_pk_bf16(v[2], v[3]); *(v2u*)p = w; }
__device__ __forceinline__ void shift8(const bf16* Prow, bool hasprev, int col, const float* mu, float (&o)[8]) {
    float c[8], p[8], m[8]; ld8bf(Prow + col, c); ld8f(mu + col, m);
    if (hasprev) ld8bf(Prow - PC + col, p); else {
#pragma unroll
        for (int j = 0; j < 8; ++j) p[j] = 0.f; }
#pragma unroll
    for (int j = 0; j < 8; ++j) o[j] = c[j] + (p[j] - c[j]) * m[j];
}
__device__ __forceinline__ void shift4(const bf16* Prow, bool hasprev, int col, const float* mu, float (&o)[4]) {
    float c[4], p[4], m[4]; ld4bf(Prow + col, c); ld4f(mu + col, m);
    if (hasprev) ld4bf(Prow - PC + col, p); else {
#pragma unroll
        for (int j = 0; j < 4; ++j) p[j] = 0.f; }
#pragma unroll
    for (int j = 0; j < 4; ++j) o[j] = c[j] + (p[j] - c[j]) * m[j];
}

struct Frame {
    LAS unsigned char* lds;
    unsigned* ctl;
    int tid, lane, wave, vcu, G, gw, NGW;
    int z;
    float* out; unsigned char* ws;
    __device__ __forceinline__ const float* in(int k) const { typedef const float* const __attribute__((address_space(4))) * KP; KP kin = (KP)__builtin_amdgcn_kernarg_segment_ptr(); return (const float*)(const GAS float*)kin[k + z]; }
};
__device__ __forceinline__ int lane_id() { int l; asm volatile("v_mbcnt_lo_u32_b32 %0, -1, 0\n\tv_mbcnt_hi_u32_b32 %0, -1, %0" : "=v"(l)); return l; }
__device__ __forceinline__ void mkframe(Frame& F, LAS unsigned char* lds, unsigned char* ws, float* out, int wave_s) {
    int tid = wave_s * 64 + lane_id(); asm volatile("" : "+v"(tid));
    int z = 0; asm volatile("" : "+s"(z));
    F.lds = lds; F.z = z; F.tid = tid; F.lane = tid & 63; F.wave = wave_s;
    F.G = (int)gridDim.x + z; { const int bx = (int)blockIdx.x + z; F.vcu = (F.G % 8 == 0) ? (bx % 8) * (F.G / 8) + bx / 8 : bx; }
    F.gw = F.vcu * NWAVES + F.wave; F.NGW = F.G * NWAVES;
    F.ws = ws + z; F.out = out + z; F.ctl = (unsigned*)(F.ws + WS_CTL);
}
template <class T> __device__ __forceinline__ T* wsp(const Frame& F, size_t off) { return (T*)(F.ws + off); }

template <int MODE>
__device__ __forceinline__ void transpose_item(const float* W, int K, int N, bf16* WT, int row_off, LAS float* scr, int item, int lane) {
    const int nblk = N / 32, kb = item / nblk, nb = item % nblk, k0 = 64 * kb, n0 = 32 * nb;
#pragma unroll 8
    for (int i = 0; i < 32; ++i) { const int kk = 2 * i + (lane >> 5); scr[kk * 33 + (lane & 31)] = W[(size_t)(k0 + kk) * N + n0 + (lane & 31)]; }
    LDS_WAIT(); asm volatile("" ::: "memory");
    const int c = lane & 7;
    const int drow0 = MODE == 0 ? row_off + n0 : (n0 / 128) * 256 + (n0 % 128) + row_off;
#pragma unroll
    for (int j = 0; j < 4; ++j) { const int n = (lane >> 3) + 8 * j; const LAS float* s = scr + (8 * c) * 33 + n;
        v4u o; o.x = cvt_pk_bf16(s[0 * 33], s[1 * 33]); o.y = cvt_pk_bf16(s[2 * 33], s[3 * 33]); o.z = cvt_pk_bf16(s[4 * 33], s[5 * 33]); o.w = cvt_pk_bf16(s[6 * 33], s[7 * 33]);
        *(v4u*)(WT + (size_t)(drow0 + n) * K + k0 + 8 * c) = o; }
    LDS_WAIT(); asm volatile("" ::: "memory");
}
template <int MODE>
__device__ __forceinline__ void transpose_all(const Frame& F, const float* W, int K, int N, bf16* WT, int row_off) {
    LAS float* scr = (LAS float*)(F.lds + F.wave * 16384);
    const int nitems = (K / 64) * (N / 32);
    for (int it = F.gw; it < nitems; it += F.NGW) transpose_item<MODE>(W, K, N, WT, row_off, scr, it, F.lane);
}

__device__ __forceinline__ void p0_prologue(const Frame& F) {
    for (int l = 0; l < 2; ++l) {
        transpose_all<0>(F, F.in(1) + (size_t)l * D * 6144, D, 6144, wsp<bf16>(F, WS_WIN) + (size_t)l * 6144 * D, 0);
        transpose_all<0>(F, F.in(13) + (size_t)l * RW * D, RW, D, wsp<bf16>(F, WS_WOA) + (size_t)l * D * RW, 0);
        transpose_all<0>(F, F.in(18) + (size_t)l * 256 * D, 256, D, wsp<bf16>(F, WS_WOB) + (size_t)l * D * 256, 0);
        transpose_all<0>(F, F.in(20) + (size_t)l * 256 * D, 256, D, wsp<bf16>(F, WS_WOC) + (size_t)l * D * 256, 0);
        transpose_all<0>(F, F.in(21) + (size_t)l * D * D, D, D, wsp<bf16>(F, WS_WOUT) + (size_t)l * D * D, 0);
        bf16* WL = wsp<bf16>(F, WS_WLORA) + (size_t)l * (MiB / 2);
        const float* w2 = F.in(4) + (size_t)l * 64 * RW; const float* a2 = F.in(6) + (size_t)l * 64 * RW; const float* g2 = F.in(7) + (size_t)l * 128 * RW;
        for (int idx = F.gw * 64 + F.lane; idx < 1536 * 256; idx += F.NGW * 64) {
            const int n = idx >> 8, k = idx & 255; float v = 0.f;
            if (n < 512) { if (k < 64) v = w2[k * RW + n]; }
            else if (n < 1024) { if (k >= 64 && k < 128) v = a2[(k - 64) * RW + (n - 512)]; }
            else { if (k >= 128) v = g2[(k - 128) * RW + (n - 1024)]; }
            WL[idx] = (bf16)(cvt_pk_bf16(v, 0.f) & 0xffffu);
        }
    }
    transpose_all<1>(F, F.in(24), D, DFF, wsp<bf16>(F, WS_WGU), 0);
    transpose_all<1>(F, F.in(25), D, DFF, wsp<bf16>(F, WS_WGU), 128);
    transpose_all<0>(F, F.in(26), DFF, D, wsp<bf16>(F, WS_WD), 0);
    const float* x = F.in(0); bf16* xb = wsp<bf16>(F, WS_XB);
    for (size_t i = ((size_t)F.gw * 64 + F.lane) * 8; i < (size_t)M * D; i += (size_t)F.NGW * 64 * 8) { float v[8]; ld8f(x + i, v); st8bf(xb + i, v); }
}
__device__ __forceinline__ void moe_weights(const Frame& F) {
    for (int e = 0; e < NE; ++e) {
        transpose_all<1>(F, F.in(28) + (size_t)e * D * DFF, D, DFF, wsp<bf16>(F, WS_MOEWGU) + (size_t)e * 2 * DFF * D, 0);
        transpose_all<1>(F, F.in(29) + (size_t)e * D * DFF, D, DFF, wsp<bf16>(F, WS_MOEWGU) + (size_t)e * 2 * DFF * D, 128);
        transpose_all<0>(F, F.in(30) + (size_t)e * DFF * D, DFF, D, wsp<bf16>(F, WS_MOEWD) + (size_t)e * D * DFF, 0);
    }
}

__device__ __forceinline__ void phase_b(const Frame& F, int l) {
    const bf16* P = wsp<bf16>(F, WS_P);
    {
        LAS float* U = (LAS float*)F.lds; LAS float* DW = (LAS float*)(F.lds + 94 * 1024);
        const float* dw = F.in(14) + (size_t)l * 31 * 256; const float* dwb = F.in(15) + l * 256; const float* lg = F.in(16) + l * 256; const float* lb = F.in(17) + l * 256;
        bf16* UB = wsp<bf16>(F, WS_UB);
        for (int u = F.vcu; u < TB / 64; u += F.G) {
            const int t0 = u * 64;
            for (int idx = F.tid; idx < 94 * 32; idx += 512) { const int row = idx >> 5, g8 = idx & 31, t = t0 - 30 + row; float o[8];
                if (t >= 0) { float a[8], g[8]; ld8bf(P + (size_t)t * PC + 1792 + 8 * g8, a); ld8bf(P + (size_t)t * PC + 2048 + 8 * g8, g);
#pragma unroll
                    for (int j = 0; j < 8; ++j) o[j] = a[j] * sigm(g[j]); }
                else {
#pragma unroll
                    for (int j = 0; j < 8; ++j) o[j] = 0.f; }
                *(LAS f32x4*)(U + row * 256 + 8 * g8) = (f32x4){o[0], o[1], o[2], o[3]}; *(LAS f32x4*)(U + row * 256 + 8 * g8 + 4) = (f32x4){o[4], o[5], o[6], o[7]}; }
            for (int idx = F.tid; idx < 31 * 64; idx += 512) *(LAS f32x4*)(DW + 4 * idx) = *(const f32x4*)(dw + 4 * idx);
            __syncthreads();
            const int c = 4 * F.lane; const f32x4 bias = *(const f32x4*)(dwb + c), gg = *(const f32x4*)(lg + c), bb = *(const f32x4*)(lb + c);
            for (int i = 0; i < 8; ++i) { const int tt = F.wave * 8 + i; f32x4 acc = bias;
#pragma unroll
                for (int j = 0; j < 31; ++j) acc += *(const LAS f32x4*)(DW + j * 256 + c) * *(const LAS f32x4*)(U + (tt + j) * 256 + c);
                const float mean = wave_sum((acc[0] + acc[1]) + (acc[2] + acc[3])) * (1.f / 256.f); const f32x4 d = acc - mean;
                const float var = wave_sum((d[0] * d[0] + d[1] * d[1]) + (d[2] * d[2] + d[3] * d[3])) * (1.f / 256.f); const float rstd = 1.f / sqrtf(var + LN_EPS);
                float y[4];
#pragma unroll
                for (int j = 0; j < 4; ++j) { const float z = d[j] * rstd * gg[j] + bb[j]; y[j] = z * sigm(z); }
                st4bf(UB + (size_t)(t0 + tt) * 256 + c, y); }
            __syncthreads();
        }
    }
    {
        bf16* LA = wsp<bf16>(F, WS_LA); const float* mu = F.in(2) + (size_t)l * 1792;
        for (int tp = F.gw; tp < TB / 2; tp += F.NGW) { const int t = 2 * tp + (F.lane >> 5), j8 = F.lane & 31; float v[8];
            shift8(P + (size_t)t * PC, t > 0, 1536 + 8 * j8, mu, v);
            if (j8 < 8) {
#pragma unroll
                for (int j = 0; j < 8; ++j) v[j] = 1.f - 2.f * __builtin_amdgcn_rcpf(1.f + __expf(2.f * v[j])); }
            else if (j8 >= 16) {
#pragma unroll
                for (int j = 0; j < 8; ++j) v[j] = sigm(v[j]); }
            st8bf(LA + (size_t)t * 256 + 8 * j8, v); }
    }
    {
        bf16* UC = wsp<bf16>(F, WS_UC); const float* dw = F.in(19) + (size_t)l * 3 * 256;
        const int c = 4 * F.lane; f32x4 w[3];
#pragma unroll
        for (int d = 0; d < 3; ++d) w[d] = *(const f32x4*)(dw + d * 256 + c);
        for (int t = F.gw; t < TB; t += F.NGW) { float gb[4]; ld4bf(P + (size_t)t * PC + 2304 + c, gb); float acc[4] = {0.f, 0.f, 0.f, 0.f};
#pragma unroll
            for (int d = 0; d < 3; ++d) { const int tt = t - 2 + d; if (tt >= 0) { float gc[4], h[4]; ld4bf(P + (size_t)tt * PC + 2560 + c, gc); ld4bf(P + (size_t)tt * PC + 2816 + c, h);
#pragma unroll
                    for (int j = 0; j < 4; ++j) acc[j] += w[d][j] * gc[j] * h[j]; } }
#pragma unroll
            for (int j = 0; j < 4; ++j) acc[j] *= gb[j];
            st4bf(UC + (size_t)t * 256 + c, acc); }
    }
}

__device__ __forceinline__ void phase_scan_naive(const Frame& F, int l) {
    const int h = (int)blockIdx.x + F.z;
    if (h >= NH) return;
    const bf16* P = wsp<bf16>(F, WS_P); const bf16* AA = wsp<bf16>(F, WS_AA); const float* LD = wsp<float>(F, WS_LD); float* O = wsp<float>(F, WS_O);
    const float* mu = F.in(2) + (size_t)l * 1792; const float* k_k = F.in(8) + l * RW; const float* k_a = F.in(9) + l * RW;
    LAS float* L = (LAS float*)F.lds;
    const int tt = F.tid >> 4, cg = F.tid & 15, c = 4 * cg, col = h * HD + c;
    float kk4[4], ka4[4]; ld4f(k_k + col, kk4); ld4f(k_a + col, ka4);
    float r4[4], k4[4], v4[4], a4[4], ld4[4];
    auto load_block = [&](int blk) { const int t = blk * 32 + tt; const bf16* pr = P + (size_t)t * PC;
        shift4(pr, t > 0, col, mu, r4); shift4(pr, t > 0, 512 + col, mu, k4); shift4(pr, t > 0, 1024 + col, mu, v4);
        ld4bf(AA + (size_t)t * RW + col, a4); ld4f(LD + (size_t)t * RW + col, ld4); };
    auto write_block = [&](int buf) { LAS float* B = L + buf * (6 * 32 * 64) + tt * 64 + c;
        float kx[4], ss = 0.f;
#pragma unroll
        for (int j = 0; j < 4; ++j) { kx[j] = k4[j] * kk4[j]; ss += kx[j] * kx[j]; }
        ss += __shfl_xor(ss, 1); ss += __shfl_xor(ss, 2); ss += __shfl_xor(ss, 4); ss += __shfl_xor(ss, 8);
        const float inv = 1.f / fmaxf(sqrtf(ss), 1e-12f);
        f32x4 dec, kap, kb, kp;
#pragma unroll
        for (int j = 0; j < 4; ++j) { dec[j] = __expf(ld4[j]); kap[j] = kx[j] * inv; kb[j] = kap[j] * a4[j]; kp[j] = k4[j] * (1.f + (a4[j] - 1.f) * ka4[j]); }
        *(LAS f32x4*)(B + 0 * 2048) = dec; *(LAS f32x4*)(B + 1 * 2048) = kap; *(LAS f32x4*)(B + 2 * 2048) = kb; *(LAS f32x4*)(B + 3 * 2048) = kp;
        *(LAS f32x4*)(B + 4 * 2048) = (f32x4){r4[0], r4[1], r4[2], r4[3]}; *(LAS f32x4*)(B + 5 * 2048) = (f32x4){v4[0], v4[1], v4[2], v4[3]}; };
    const int vl = F.lane >> 3, kq = F.lane & 7, vrow = F.wave * 8 + vl, k0 = 8 * kq;
    float s[8];
#pragma unroll
    for (int j = 0; j < 8; ++j) s[j] = 0.f;
    load_block(0); write_block(0); __syncthreads();
    for (int blk = 0; blk < TB / 32; ++blk) {
        const int buf = blk & 1;
        if (blk + 1 < TB / 32) load_block(blk + 1);
        const LAS float* B = L + buf * (6 * 32 * 64);
        for (int i = 0; i < 32; ++i) {
            const LAS float* Bi = B + i * 64 + k0;
            float dec[8], kap[8], kb[8], kp[8], rr[8];
#pragma unroll
            for (int q = 0; q < 2; ++q) { const f32x4 a = *(const LAS f32x4*)(Bi + 0 * 2048 + 4 * q), b = *(const LAS f32x4*)(Bi + 1 * 2048 + 4 * q), cc = *(const LAS f32x4*)(Bi + 2 * 2048 + 4 * q), d = *(const LAS f32x4*)(Bi + 3 * 2048 + 4 * q), e = *(const LAS f32x4*)(Bi + 4 * 2048 + 4 * q);
#pragma unroll
                for (int j = 0; j < 4; ++j) { dec[4 * q + j] = a[j]; kap[4 * q + j] = b[j]; kb[4 * q + j] = cc[j]; kp[4 * q + j] = d[j]; rr[4 * q + j] = e[j]; } }
            const float vv = B[5 * 2048 + i * 64 + vrow];
            float sa = 0.f;
#pragma unroll
            for (int j = 0; j < 8; ++j) sa -= s[j] * kap[j];
            sa = red8(sa);
            float o = 0.f;
#pragma unroll
            for (int j = 0; j < 8; ++j) { s[j] = s[j] * dec[j] + sa * kb[j] + vv * kp[j]; o += s[j] * rr[j]; }
            o = red8(o);
            if (kq == 0) O[(size_t)(blk * 32 + i) * RW + h * HD + vrow] = o;
        }
        if (blk + 1 < TB / 32) write_block(buf ^ 1);
        __syncthreads();
    }
}

__device__ __forceinline__ void phase_post(const Frame& F, int l) {
    const bf16* P = wsp<bf16>(F, WS_P); const bf16* AA = wsp<bf16>(F, WS_AA); const bf16* GG = wsp<bf16>(F, WS_GG); const float* O = wsp<float>(F, WS_O); bf16* OA = wsp<bf16>(F, WS_OA);
    const float* mu = F.in(2) + (size_t)l * 1792;
    const int c = 8 * F.lane; float ka[8], rk[8], lg[8], lb[8];
    ld8f(F.in(9) + l * RW + c, ka); ld8f(F.in(10) + l * RW + c, rk); ld8f(F.in(11) + l * RW + c, lg); ld8f(F.in(12) + l * RW + c, lb);
    for (int t = F.gw; t < TB; t += F.NGW) {
        float o[8], r[8], k[8], v[8], a[8], g[8]; const bf16* pr = P + (size_t)t * PC;
        ld8f(O + (size_t)t * RW + c, o); shift8(pr, t > 0, c, mu, r); shift8(pr, t > 0, 512 + c, mu, k); shift8(pr, t > 0, 1024 + c, mu, v);
        ld8bf(AA + (size_t)t * RW + c, a); ld8bf(GG + (size_t)t * RW + c, g);
        float s = 0.f;
#pragma unroll
        for (int j = 0; j < 8; ++j) s += o[j];
        const float mean = red8(s) * (1.f / 64.f); float q = 0.f, bon = 0.f;
#pragma unroll
        for (int j = 0; j < 8; ++j) { o[j] -= mean; q += o[j] * o[j]; bon += r[j] * k[j] * (1.f + (a[j] - 1.f) * ka[j]) * rk[j]; }
        const float rstd = 1.f / sqrtf(red8(q) * (1.f / 64.f) + GN_EPS); bon = red8(bon);
        float y[8];
#pragma unroll
        for (int j = 0; j < 8; ++j) y[j] = (o[j] * rstd * lg[j] + lb[j] + bon * v[j]) * g[j];
        st8bf(OA + (size_t)t * RW + c, y);
    }
}

__device__ __forceinline__ void ln_row(float* xrow, bf16* brow, const float* g, const float* b, int lane) {
    f32x4 v[4]; float s = 0.f;
#pragma unroll
    for (int j = 0; j < 4; ++j) { v[j] = *(const f32x4*)(xrow + 4 * lane + 256 * j); s += (v[j][0] + v[j][1]) + (v[j][2] + v[j][3]); }
    const float mean = wave_sum(s) * (1.f / D); float s2 = 0.f;
#pragma unroll
    for (int j = 0; j < 4; ++j) { v[j] = v[j] - mean; s2 += (v[j][0] * v[j][0] + v[j][1] * v[j][1]) + (v[j][2] * v[j][2] + v[j][3] * v[j][3]); }
    const float rstd = 1.f / sqrtf(wave_sum(s2) * (1.f / D) + LN_EPS);
#pragma unroll
    for (int j = 0; j < 4; ++j) { const f32x4 gg = *(const f32x4*)(g + 4 * lane + 256 * j), bb = *(const f32x4*)(b + 4 * lane + 256 * j); const f32x4 y = v[j] * rstd * gg + bb;
        *(f32x4*)(xrow + 4 * lane + 256 * j) = y;
        if (brow) { v2u w; w.x = cvt_pk_bf16(y[0], y[1]); w.y = cvt_pk_bf16(y[2], y[3]); *(v2u*)(brow + 4 * lane + 256 * j) = w; } }
}
__device__ __forceinline__ void phase_ln(const Frame& F, int r0, int nrows, const float* g, const float* b) {
    bf16* xb = wsp<bf16>(F, WS_XB);
    for (int m = F.gw; m < nrows; m += F.NGW) ln_row(F.out + (size_t)(r0 + m) * D, xb + (size_t)(r0 + m) * D, g, b, F.lane);
}

__device__ __forceinline__ void phase_router(const Frame& F) {
    LAS float* WR = (LAS float*)F.lds; LAS unsigned* lcnt = (LAS unsigned*)(F.lds + 32768);
    const float* wr = F.in(27);
    for (int i = F.tid; i < D * NE / 4; i += 512) *(LAS f32x4*)(WR + 4 * i) = *(const f32x4*)(wr + 4 * i);
    if (F.tid < NE) lcnt[F.tid] = 0u;
    __syncthreads();
    int* TOKE = wsp<int>(F, WS_TOKE); f32x2* TOKW = wsp<f32x2>(F, WS_TOKW);
    for (int t = F.gw; t < M; t += F.NGW) {
        const float* xr = F.out + (size_t)t * D; float lg[NE];
#pragma unroll
        for (int e = 0; e < NE; ++e) lg[e] = 0.f;
#pragma unroll
        for (int j = 0; j < 4; ++j) { const f32x4 xv = *(const f32x4*)(xr + 4 * F.lane + 256 * j);
#pragma unroll
            for (int q = 0; q < 4; ++q) { const LAS float* w = WR + (4 * F.lane + 256 * j + q) * NE; const f32x4 w0 = *(const LAS f32x4*)w, w1 = *(const LAS f32x4*)(w + 4);
                lg[0] += xv[q] * w0[0]; lg[1] += xv[q] * w0[1]; lg[2] += xv[q] * w0[2]; lg[3] += xv[q] * w0[3]; lg[4] += xv[q] * w1[0]; lg[5] += xv[q] * w1[1]; lg[6] += xv[q] * w1[2]; lg[7] += xv[q] * w1[3]; } }
#pragma unroll
        for (int e = 0; e < NE; ++e) lg[e] = wave_sum(lg[e]);
        int e1 = 0; float l1 = lg[0];
#pragma unroll
        for (int e = 1; e < NE; ++e) if (lg[e] > l1) { l1 = lg[e]; e1 = e; }
        int e2 = -1; float l2 = -3.0e38f;
#pragma unroll
        for (int e = 0; e < NE; ++e) if (e != e1 && lg[e] > l2) { l2 = lg[e]; e2 = e; }
        const float ex = __expf(l2 - l1), w1 = 1.f / (1.f + ex), w2 = ex * w1;
        if (F.lane == 0) { TOKE[t] = e1 | (e2 << 8); TOKW[t] = (f32x2){w1, w2}; atomicAdd((unsigned*)&lcnt[e1], 1u); atomicAdd((unsigned*)&lcnt[e2], 1u); }
    }
    __syncthreads();
    if (F.tid < NE && lcnt[F.tid]) __hip_atomic_fetch_add(F.ctl + CW_MOE + 64 * F.tid, lcnt[F.tid], RLX_AGENT);
}
__device__ __forceinline__ void phase_assign(const Frame& F) {
    LAS unsigned* lc = (LAS unsigned*)F.lds;
    LAS int* lslot = (LAS int*)(F.lds + 256);
    const int* TOKE = wsp<int>(F, WS_TOKE); int* SLOT = wsp<int>(F, WS_SLOT); int* BLKE = wsp<int>(F, WS_BLKE);
    unsigned cnt[NE], pst[NE]; unsigned acc = 0;
#pragma unroll
    for (int e = 0; e < NE; ++e) { cnt[e] = __hip_atomic_load(F.ctl + CW_MOE + 64 * e, RLX_AGENT); pst[e] = acc; acc += ((cnt[e] + 255u) >> 8) << 8; }
    const int nblk = (int)(acc >> 8);
    if (F.tid < NE) lc[F.tid] = 0u;
    if (F.tid == 0) {
#pragma unroll
        for (int e = 0; e < NE; ++e) lc[16 + e] = pst[e]; }
    __syncthreads();
    if ((int)blockIdx.x + F.z == 0) { for (int i = F.tid; i <= NBLK_MAX; i += 512) { int e = 0;
#pragma unroll
            for (int q = 1; q < NE; ++q) if ((unsigned)(i * 256) >= pst[q]) e = q;
            if (i < NBLK_MAX) BLKE[i] = e; else BLKE[NBLK_MAX] = nblk; } }
    const int tpw = M / F.G;
    const int t0 = F.vcu * tpw;
    int e1 = 0, e2 = 0, r1 = 0, r2 = 0;
    for (int base = 0; base < tpw; base += 512) {
        const int i = base + F.tid;
        if (i < tpw) { const int te = TOKE[t0 + i]; e1 = te & 255; e2 = te >> 8; r1 = (int)atomicAdd((unsigned*)&lc[e1], 1u); r2 = (int)atomicAdd((unsigned*)&lc[e2], 1u); }
    }
    __syncthreads();
    if (F.tid < NE) lc[8 + F.tid] = lc[F.tid] ? __hip_atomic_fetch_add(F.ctl + CW_MOE + 64 * (8 + F.tid), lc[F.tid], RLX_AGENT) : 0u;
    __syncthreads();
    if (F.tid < tpw) { const int s1 = (int)(lc[16 + e1] + lc[8 + e1]) + r1, s2 = (int)(lc[16 + e2] + lc[8 + e2]) + r2; lslot[2 * F.tid] = s1; lslot[2 * F.tid + 1] = s2; SLOT[2 * (t0 + F.tid)] = s1; SLOT[2 * (t0 + F.tid) + 1] = s2; }
    __syncthreads();
    const bf16* xb = wsp<bf16>(F, WS_XB); bf16* XG = wsp<bf16>(F, WS_XG);
    for (int i = F.wave; i < tpw; i += NWAVES) { const v4u* src = (const v4u*)(xb + (size_t)(t0 + i) * D); const v4u a = src[F.lane], b = src[64 + F.lane];
#pragma unroll
        for (int q = 0; q < 2; ++q) { v4u* dst = (v4u*)(XG + (size_t)lslot[2 * i + q] * D); dst[F.lane] = a; dst[64 + F.lane] = b; } }
}
__device__ __forceinline__ void phase_combine(const Frame& F, const float* g, const float* b) {
    const bf16* YD = wsp<bf16>(F, WS_XG); const int* SLOT = wsp<int>(F, WS_SLOT); const f32x2* TOKW = wsp<f32x2>(F, WS_TOKW);
    for (int t = F.gw; t < M; t += F.NGW) {
        float* xrow = F.out + (size_t)t * D; const int s1 = SLOT[2 * t], s2 = SLOT[2 * t + 1]; const f32x2 w = TOKW[t];
        const bf16* y1 = YD + (size_t)s1 * D; const bf16* y2 = YD + (size_t)s2 * D;
#pragma unroll
        for (int j = 0; j < 4; ++j) { const int cidx = 4 * F.lane + 256 * j; f32x4 v = *(const f32x4*)(xrow + cidx); float a[4], c[4]; ld4bf(y1 + cidx, a); ld4bf(y2 + cidx, c);
#pragma unroll
            for (int q = 0; q < 4; ++q) v[q] = v[q] * ALPHA + w[0] * a[q] + w[1] * c[q];
            *(f32x4*)(xrow + cidx) = v; }
        ln_row(xrow, nullptr, g, b, F.lane);
    }
}


typedef float f32x16 __attribute__((ext_vector_type(16)));
typedef short bf16x8v __attribute__((ext_vector_type(8)));
constexpr int LS = 72;
constexpr int MBYTES = 64 * LS * 2;
constexpr int SC_GAM = RING_BYTES + 1024, SC_SUM = RING_BYTES + 2048;
constexpr int NCHUNK = TB / 64;
__device__ __forceinline__ LAS bf16* mbuf(LAS unsigned char* lds, int i) { return (LAS bf16*)(lds + i * MBYTES); }
__device__ __forceinline__ f32x16 mm64(const LAS bf16* Aop, const LAS bf16* Bop, int xt, int yt, int lane, f32x16 acc) {
    const int r = lane & 31, h = lane >> 5;
    const LAS bf16* ap = Aop + (32 * xt + r) * LS + 8 * h; const LAS bf16* bp = Bop + (32 * yt + r) * LS + 8 * h;
#pragma unroll
    for (int s = 0; s < 4; ++s) { const bf16x8v a = *(const LAS bf16x8v*)(ap + 16 * s), b = *(const LAS bf16x8v*)(bp + 16 * s); acc = __builtin_amdgcn_mfma_f32_32x32x16_bf16(a, b, acc, 0, 0, 0); }
    return acc;
}
__device__ __forceinline__ void store_t(LAS bf16* Dt, int xt, int yt, int lane, const f32x16& acc) {
    const int c = lane & 31, h = lane >> 5; LAS bf16* p = Dt + (32 * yt + c) * LS + 32 * xt + 4 * h;
#pragma unroll
    for (int g = 0; g < 4; ++g) { v2u w; w.x = cvt_pk_bf16(acc[4 * g], acc[4 * g + 1]); w.y = cvt_pk_bf16(acc[4 * g + 2], acc[4 * g + 3]); *(LAS v2u*)(p + 8 * g) = w; }
}
__device__ __forceinline__ f32x16 zero16() { f32x16 z;
#pragma unroll
    for (int i = 0; i < 16; ++i) z[i] = 0.f;
    return z; }
__device__ __forceinline__ unsigned short bf1(float v) { return (unsigned short)(cvt_pk_bf16(v, 0.f) & 0xffffu); }

__device__ __forceinline__ void phase_c1(const Frame& F, int l) {
    const bf16* P = wsp<bf16>(F, WS_P); const bf16* AA = wsp<bf16>(F, WS_AA); const float* LD = wsp<float>(F, WS_LD); float* O = wsp<float>(F, WS_O);
    unsigned char* MCg = wsp<unsigned char>(F, WS_MC); unsigned char* NCg = wsp<unsigned char>(F, WS_NC); unsigned char* QEg = wsp<unsigned char>(F, WS_QE);
    const float* mu = F.in(2) + (size_t)l * 1792; const float* k_k = F.in(8) + l * RW; const float* k_a = F.in(9) + l * RW;
    LAS unsigned char* lds = F.lds; LAS float* GAM = (LAS float*)(lds + SC_GAM); LAS float* SUM = (LAS float*)(lds + SC_SUM);
    const int lane = F.lane, w = F.wave, c = lane & 31, hh = lane >> 5;
    enum { KT = 0, KTT = 1, RT = 2, BT = 3, KI = 4, VT = 5, BH = 6, KH = 7, AK = 8, RB = 9, RK = 10, XA = 11, PA = 12, PTA = 13 };
    for (int u = F.vcu; u < NH * NCHUNK; u += F.G) {
        const int h = u / NCHUNK, ch = u % NCHUNK, t0 = ch * 64;
        {
            const int k = lane, tq = w, col = h * HD + k; const int tb = t0 + 8 * tq;
            const float mur = mu[col], muk = mu[512 + col], muv = mu[1024 + col], kkw = k_k[col], kaw = k_a[col];
            float pr = 0.f, pk = 0.f, pv = 0.f;
            if (tb > 0) { const bf16* pp = P + (size_t)(tb - 1) * PC + col; pr = bflo(pp[0]); pk = bflo(pp[512]); pv = bflo(pp[1024]); }
            float rr[8], kp[8], vv[8], kap[8], be[8], ldv[8], Ll[8]; float run = 0.f;
#pragma unroll
            for (int i = 0; i < 8; ++i) { const bf16* pp = P + (size_t)(tb + i) * PC + col; const float cr = bflo(pp[0]), ck = bflo(pp[512]), cv = bflo(pp[1024]);
                rr[i] = cr + (pr - cr) * mur; const float kx = ck + (pk - ck) * muk; vv[i] = cv + (pv - cv) * muv; pr = cr; pk = ck; pv = cv;
                const float a = bflo(AA[(size_t)(tb + i) * RW + col]); ldv[i] = LD[(size_t)(tb + i) * RW + col];
                const float kk = kx * kkw; const float ss = wave_sum(kk * kk); kap[i] = kk / fmaxf(sqrtf(ss), 1e-12f);
                kp[i] = kx * (1.f + (a - 1.f) * kaw); be[i] = kap[i] * a; run += ldv[i]; Ll[i] = run; }
            SUM[tq * 64 + k] = run;
            __syncthreads();
            float off = 0.f, tot = 0.f;
#pragma unroll
            for (int g = 0; g < 8; ++g) { const float sg = SUM[g * 64 + k]; tot += sg; if (g < tq) off += sg; }
            if (tq == 0) GAM[k] = __expf(tot);
            float ktt[8], vt[8], bh[8], kh[8];
#pragma unroll
            for (int i = 0; i < 8; ++i) { const float L = off + Ll[i]; const float eL = __expf(L), eLp = __expf(L - ldv[i]), eiL = __expf(-L), eD = __expf(tot - L); const int t = 8 * tq + i;
                const float ktv = kap[i] * eLp; ktt[i] = ktv; vt[i] = vv[i]; bh[i] = be[i] * eD; kh[i] = kp[i] * eD;
                mbuf(lds, KT)[t * LS + k] = bf1(ktv); mbuf(lds, RT)[t * LS + k] = bf1(rr[i] * eL); mbuf(lds, BT)[t * LS + k] = bf1(be[i] * eiL); mbuf(lds, KI)[t * LS + k] = bf1(kp[i] * eiL); }
            { v4u q; q.x = cvt_pk_bf16(ktt[0], ktt[1]); q.y = cvt_pk_bf16(ktt[2], ktt[3]); q.z = cvt_pk_bf16(ktt[4], ktt[5]); q.w = cvt_pk_bf16(ktt[6], ktt[7]); *(LAS v4u*)(mbuf(lds, KTT) + k * LS + 8 * tq) = q; }
            { v4u q; q.x = cvt_pk_bf16(vt[0], vt[1]); q.y = cvt_pk_bf16(vt[2], vt[3]); q.z = cvt_pk_bf16(vt[4], vt[5]); q.w = cvt_pk_bf16(vt[6], vt[7]); *(LAS v4u*)(mbuf(lds, VT) + k * LS + 8 * tq) = q; }
            { v4u q; q.x = cvt_pk_bf16(bh[0], bh[1]); q.y = cvt_pk_bf16(bh[2], bh[3]); q.z = cvt_pk_bf16(bh[4], bh[5]); q.w = cvt_pk_bf16(bh[6], bh[7]); *(LAS v4u*)(mbuf(lds, BH) + k * LS + 8 * tq) = q; }
            { v4u q; q.x = cvt_pk_bf16(kh[0], kh[1]); q.y = cvt_pk_bf16(kh[2], kh[3]); q.z = cvt_pk_bf16(kh[4], kh[5]); q.w = cvt_pk_bf16(kh[6], kh[7]); *(LAS v4u*)(mbuf(lds, KH) + k * LS + 8 * tq) = q; }
        }
        __syncthreads();
        for (int j = w; j < 20; j += NWAVES) { const int p = j >> 2, xt = (j >> 1) & 1, yt = j & 1;
            const int ia = (p == 1) ? KT : ((p == 2 || p == 4) ? KI : BT), ib = (p == 1) ? BT : (p >= 3 ? RT : KT), id = (p == 0) ? PA : (p == 1 ? PTA : (p == 2 ? AK : (p == 3 ? RB : RK)));
            f32x16 acc = mm64(mbuf(lds, ia), mbuf(lds, ib), xt, yt, lane, zero16());
#pragma unroll
            for (int g = 0; g < 4; ++g)
#pragma unroll
                for (int e = 0; e < 4; ++e) { const int x = 32 * xt + 8 * g + 4 * hh + e, y = 32 * yt + c; const int tt = (p == 1) ? x : y, jj = (p == 1) ? y : x;
                    const bool keep = (p <= 2) ? (tt > jj) : (tt >= jj); acc[4 * g + e] = keep ? acc[4 * g + e] : 0.f; }
            store_t(mbuf(lds, id), xt, yt, lane, acc);
            if (p == 0) { f32x16 x0;
#pragma unroll
                for (int g = 0; g < 4; ++g)
#pragma unroll
                    for (int e = 0; e < 4; ++e) { const int x = 32 * xt + 8 * g + 4 * hh + e, y = 32 * yt + c; x0[4 * g + e] = (x == y ? 1.f : 0.f) - acc[4 * g + e]; }
                store_t(mbuf(lds, XA), xt, yt, lane, x0); }
        }
        __syncthreads();
#pragma unroll 1
        for (int st = 0; st < 6; ++st) {
            const int pin = (st & 1) ? BT : PA, ptin = (st & 1) ? KI : PTA, pout = (st & 1) ? PA : BT, ptout = (st & 1) ? PTA : KI;
            const int xin = (st & 1) ? XA : KT, xout = (st & 1) ? KT : XA;
            for (int j = w; j < 12; j += NWAVES) { const int kind = j >> 2, xt = (j >> 1) & 1, yt = j & 1;
                if (kind == 0) { if (st < 5) { const f32x16 acc = mm64(mbuf(lds, ptin), mbuf(lds, pin), xt, yt, lane, zero16()); store_t(mbuf(lds, pout), xt, yt, lane, acc); } }
                else if (kind == 1) { if (st < 5) { const f32x16 acc = mm64(mbuf(lds, pin), mbuf(lds, ptin), xt, yt, lane, zero16()); store_t(mbuf(lds, ptout), xt, yt, lane, acc); } }
                else if (st >= 1) { f32x16 acc; const LAS bf16* xp = mbuf(lds, xin) + (32 * yt + c) * LS + 32 * xt + 4 * hh;
#pragma unroll
                    for (int g = 0; g < 4; ++g) { const v2u q = *(const LAS v2u*)(xp + 8 * g); acc[4 * g] = bflo(q.x); acc[4 * g + 1] = bfhi(q.x); acc[4 * g + 2] = bflo(q.y); acc[4 * g + 3] = bfhi(q.y); }
                    acc = mm64(mbuf(lds, ptin), mbuf(lds, xin), xt, yt, lane, acc); store_t(mbuf(lds, xout), xt, yt, lane, acc); }
            }
            __syncthreads();
        }
        { const int kind = w >> 2, xt = (w >> 1) & 1, yt = w & 1;
            if (kind == 0) { const f32x16 acc = mm64(mbuf(lds, AK), mbuf(lds, VT), xt, yt, lane, zero16()); store_t(mbuf(lds, BT), xt, yt, lane, acc); }
            else { f32x16 acc = mm64(mbuf(lds, KT), mbuf(lds, KTT), xt, yt, lane, zero16());
#pragma unroll
                for (int i = 0; i < 16; ++i) acc[i] = -acc[i];
                store_t(mbuf(lds, KI), xt, yt, lane, acc); } }
        __syncthreads();
        const size_t ug = (size_t)u;
        { const int xt = (w >> 1) & 1, yt = w & 1;
            if (w < 4) { f32x16 acc = mm64(mbuf(lds, KT), mbuf(lds, BT), xt, yt, lane, zero16());
#pragma unroll
                for (int i = 0; i < 16; ++i) acc[i] = -acc[i];
                store_t(mbuf(lds, XA), xt, yt, lane, acc); }
            else { f32x16 acc = mm64(mbuf(lds, KI), mbuf(lds, BH), xt, yt, lane, zero16());
                if (xt == yt) {
#pragma unroll
                    for (int g = 0; g < 4; ++g)
#pragma unroll
                        for (int e = 0; e < 4; ++e) if (8 * g + 4 * hh + e == c) acc[4 * g + e] += GAM[32 * xt + c]; }
                v4u* dst = (v4u*)(MCg + ug * 8192 + (size_t)((xt * 2 + yt) * 2) * 1024) + lane;
#pragma unroll
                for (int s = 0; s < 2; ++s) { v4u q; q.x = cvt_pk_bf16(acc[8 * s], acc[8 * s + 1]); q.y = cvt_pk_bf16(acc[8 * s + 2], acc[8 * s + 3]); q.z = cvt_pk_bf16(acc[8 * s + 4], acc[8 * s + 5]); q.w = cvt_pk_bf16(acc[8 * s + 6], acc[8 * s + 7]); dst[64 * s] = q; } } }
        __syncthreads();
        { const int xt = (w >> 1) & 1, yt = w & 1;
            if (w < 4) {
                f32x16 acc = mm64(mbuf(lds, BH), mbuf(lds, XA), xt, yt, lane, zero16());
                acc = mm64(mbuf(lds, KH), mbuf(lds, VT), xt, yt, lane, acc);
                f32x4* dn = (f32x4*)(NCg + ug * 16384 + (size_t)((xt * 2 + yt) * 4) * 1024) + lane;
#pragma unroll
                for (int q = 0; q < 4; ++q) dn[64 * q] = (f32x4){acc[4 * q], acc[4 * q + 1], acc[4 * q + 2], acc[4 * q + 3]};
                f32x16 qe; const LAS bf16* rp = mbuf(lds, RT) + (32 * yt + c) * LS + 32 * xt + 4 * hh;
#pragma unroll
                for (int g = 0; g < 4; ++g) { const v2u q = *(const LAS v2u*)(rp + 8 * g); qe[4 * g] = bflo(q.x); qe[4 * g + 1] = bfhi(q.x); qe[4 * g + 2] = bflo(q.y); qe[4 * g + 3] = bfhi(q.y); }
                qe = mm64(mbuf(lds, KI), mbuf(lds, RB), xt, yt, lane, qe);
                v4u* dq = (v4u*)(QEg + ug * 8192 + (size_t)((xt * 2 + yt) * 2) * 1024) + lane;
#pragma unroll
                for (int s = 0; s < 2; ++s) { v4u q; q.x = cvt_pk_bf16(qe[8 * s], qe[8 * s + 1]); q.y = cvt_pk_bf16(qe[8 * s + 2], qe[8 * s + 3]); q.z = cvt_pk_bf16(qe[8 * s + 4], qe[8 * s + 5]); q.w = cvt_pk_bf16(qe[8 * s + 6], qe[8 * s + 7]); dq[64 * s] = q; }
            } else {
                f32x16 acc = mm64(mbuf(lds, RB), mbuf(lds, XA), xt, yt, lane, zero16());
                acc = mm64(mbuf(lds, RK), mbuf(lds, VT), xt, yt, lane, acc);
                float* op = O + (size_t)(t0 + 32 * xt + 4 * hh) * RW + h * HD + 32 * yt + c;
#pragma unroll
                for (int g = 0; g < 4; ++g)
#pragma unroll
                    for (int e = 0; e < 4; ++e) op[(size_t)(8 * g + e) * RW] = acc[4 * g + e];
            } }
        __syncthreads();
    }
}

__device__ __forceinline__ void phase_c2(const Frame& F) {
    if (F.vcu >= 2 * NH) return;
    const int h = F.vcu >> 1, vt = F.vcu & 1, lane = F.lane, w = F.wave;
    const unsigned char* MCg = wsp<unsigned char>(F, WS_MC); const unsigned char* NCg = wsp<unsigned char>(F, WS_NC); unsigned char* S0g = wsp<unsigned char>(F, WS_S0);
    LAS unsigned char* lds = F.lds;
    auto issue = [&](int chunk) { const int cc = chunk < NCHUNK ? chunk : NCHUNK - 1; const size_t u = (size_t)h * NCHUNK + cc; const int slot = chunk & 7;
#pragma unroll
        for (int i = 0; i < 4; ++i) { const int pc = 4 * (w - 1) + i;
            const unsigned char* src = pc < 8 ? MCg + u * 8192 + (size_t)pc * 1024 : NCg + u * 16384 + (size_t)((((pc - 8) >> 2) * 2 + vt) * 4 + ((pc - 8) & 3)) * 1024;
            __builtin_amdgcn_global_load_lds((const unsigned*)(src + lane * 16), (LAS unsigned*)(lds + slot * 16384 + pc * 1024), 16, 0, 0); } };
    const bool loader = (w >= 1 && w <= 4);
    if (loader) { for (int cidx = 0; cidx < 7; ++cidx) issue(cidx); asm volatile("s_waitcnt vmcnt(24)" ::: "memory"); }
    __builtin_amdgcn_s_barrier();
    f32x16 S[2]; S[0] = zero16(); S[1] = zero16();
#pragma unroll 1
    for (int ch = 0; ch < NCHUNK; ++ch) {
        if (loader) { issue(ch + 7); asm volatile("s_waitcnt vmcnt(24)" ::: "memory"); }
        else if (w == 0) {
            const LAS unsigned char* sl = lds + (ch & 7) * 16384;
            bf16x8v Sp[2][2];
#pragma unroll
            for (int kt = 0; kt < 2; ++kt)
#pragma unroll
                for (int s = 0; s < 2; ++s) { v4u q; q.x = cvt_pk_bf16(S[kt][8 * s], S[kt][8 * s + 1]); q.y = cvt_pk_bf16(S[kt][8 * s + 2], S[kt][8 * s + 3]); q.z = cvt_pk_bf16(S[kt][8 * s + 4], S[kt][8 * s + 5]); q.w = cvt_pk_bf16(S[kt][8 * s + 6], S[kt][8 * s + 7]);
                    Sp[kt][s] = __builtin_bit_cast(bf16x8v, q);
                    *((v4u*)(S0g + ((size_t)h * NCHUNK + ch) * 8192 + (size_t)(((kt * 2 + vt) * 2 + s)) * 1024) + lane) = q; }
            f32x16 acc[2];
#pragma unroll
            for (int kn = 0; kn < 2; ++kn) {
#pragma unroll
                for (int q = 0; q < 4; ++q) { const f32x4 nv = *(const LAS f32x4*)(sl + 8192 + (kn * 4 + q) * 1024 + lane * 16); acc[kn][4 * q] = nv[0]; acc[kn][4 * q + 1] = nv[1]; acc[kn][4 * q + 2] = nv[2]; acc[kn][4 * q + 3] = nv[3]; } }
#pragma unroll
            for (int kt = 0; kt < 2; ++kt)
#pragma unroll
                for (int s = 0; s < 2; ++s)
#pragma unroll
                    for (int kn = 0; kn < 2; ++kn) { const bf16x8v a = *(const LAS bf16x8v*)(sl + ((kt * 2 + kn) * 2 + s) * 1024 + lane * 16); acc[kn] = __builtin_amdgcn_mfma_f32_32x32x16_bf16(a, Sp[kt][s], acc[kn], 0, 0, 0); }
            S[0] = acc[0]; S[1] = acc[1];
            asm volatile("s_waitcnt lgkmcnt(0)" ::: "memory");
        }
        __builtin_amdgcn_s_barrier();
    }
    asm volatile("s_waitcnt vmcnt(0)" ::: "memory");
    __builtin_amdgcn_s_barrier();
}

__device__ __forceinline__ void phase_c3(const Frame& F) {
    const unsigned char* QEg = wsp<unsigned char>(F, WS_QE); const unsigned char* S0g = wsp<unsigned char>(F, WS_S0); float* O = wsp<float>(F, WS_O);
    const int lane = F.lane, c = lane & 31, hh = lane >> 5;
    for (int j = F.gw; j < NH * NCHUNK * 4; j += F.NGW) { const int u = j >> 2, tt = (j >> 1) & 1, vt = j & 1, h = u / NCHUNK, t0 = (u % NCHUNK) * 64;
        float* op = O + (size_t)(t0 + 32 * tt + 4 * hh) * RW + h * HD + 32 * vt + c; f32x16 acc;
#pragma unroll
        for (int g = 0; g < 4; ++g)
#pragma unroll
            for (int e = 0; e < 4; ++e) acc[4 * g + e] = op[(size_t)(8 * g + e) * RW];
#pragma unroll
        for (int kt = 0; kt < 2; ++kt)
#pragma unroll
            for (int s = 0; s < 2; ++s) { const v4u a = *((const v4u*)(QEg + (size_t)u * 8192 + (size_t)((kt * 2 + tt) * 2 + s) * 1024) + lane), b = *((const v4u*)(S0g + (size_t)u * 8192 + (size_t)((kt * 2 + vt) * 2 + s) * 1024) + lane);
                acc = __builtin_amdgcn_mfma_f32_32x32x16_bf16(__builtin_bit_cast(bf16x8v, a), __builtin_bit_cast(bf16x8v, b), acc, 0, 0, 0); }
#pragma unroll
        for (int g = 0; g < 4; ++g)
#pragma unroll
            for (int e = 0; e < 4; ++e) op[(size_t)(8 * g + e) * RW] = acc[4 * g + e];
    }
}

struct Args { const float* in[33]; float* out; unsigned char* ws; int ph_lo, ph_hi; };
constexpr int NPH = 1 + 4 * 10 + 3 + (2 + 2 * MOE_NCH + 1);
struct KState { LAS unsigned char* L; unsigned char* ws; float* out; int lo, hi, wave_s; XcdBarrier bar; };
#define PH_ON (K.lo <= pid && pid < K.hi)
#define PH_END do { if (K.lo <= pid && pid + 1 < K.hi) xcd_barrier(K.bar, K.wave_s == 0 && lane_id() == 0); ++pid; } while (0)
#define FRAME() Frame F; mkframe(F, K.L, K.ws, K.out, K.wave_s); LAS unsigned char* ring = F.lds; const int cid = (int)blockIdx.x + F.z; (void)ring; (void)cid

template <int l, int b> __device__ __forceinline__ void mixer_phases(const KState& K, int& pid) {
    if (PH_ON) { FRAME(); const size_t r0 = (size_t)b * TB;
        pg8::Gemm g{wsp<bf16>(F, WS_XB) + r0 * D, wsp<bf16>(F, WS_WIN) + (size_t)l * 6144 * D, TB, 6144, D}; pg8::StaticOrder S; S.init(TB, 6144, F.G, cid);
        pg8::EpiPG E{wsp<bf16>(F, WS_P), wsp<bf16>(F, WS_G)}; pg8::gemm_phase<pg8::EpiPG, pg8::StaticOrder, true, true>(ring, g, S, E, F.tid); }
    PH_END;
    if (PH_ON) { FRAME(); phase_b(F, l); }
    PH_END;
    if (PH_ON) { FRAME(); pg8::Gemm g{wsp<bf16>(F, WS_LA), wsp<bf16>(F, WS_WLORA) + (size_t)l * (MiB / 2), TB, 1536, 256}; pg8::StaticOrder S; S.init(TB, 1536, F.G, cid);
        pg8::EpiLora E{wsp<float>(F, WS_LD), wsp<bf16>(F, WS_AA), (long)((WS_GG - WS_AA) / 2), F.in(3) + l * RW, F.in(5) + l * RW}; pg8::gemm_phase<pg8::EpiLora, pg8::StaticOrder, true, true>(ring, g, S, E, F.tid); }
    PH_END;
    if (PH_ON) { FRAME(); phase_c1(F, l); }
    PH_END;
    if (PH_ON) { FRAME(); phase_c2(F); }
    PH_END;
    if (PH_ON) { FRAME(); phase_c3(F); }
    PH_END;
    if (PH_ON) { FRAME(); phase_post(F, l); }
    PH_END;
    if (PH_ON) { FRAME();
        { pg8::Gemm g{wsp<bf16>(F, WS_OA), wsp<bf16>(F, WS_WOA) + (size_t)l * D * RW, TB, D, RW}; pg8::StaticOrder S; S.init(TB, D, F.G, cid);
          pg8::EpiMerge<0> E{wsp<bf16>(F, WS_G), 0, wsp<float>(F, WS_MRG), wsp<bf16>(F, WS_MRGB)}; pg8::gemm_phase<pg8::EpiMerge<0>, pg8::StaticOrder, true, true>(ring, g, S, E, F.tid); } }
    if (PH_ON) { FRAME();
        { pg8::Gemm g{wsp<bf16>(F, WS_UB), wsp<bf16>(F, WS_WOB) + (size_t)l * D * 256, TB, D, 256}; pg8::StaticOrder S; S.init(TB, D, F.G, cid);
          pg8::EpiMerge<1> E{wsp<bf16>(F, WS_G), 1024, wsp<float>(F, WS_MRG), wsp<bf16>(F, WS_MRGB)}; pg8::gemm_phase<pg8::EpiMerge<1>, pg8::StaticOrder, true, true>(ring, g, S, E, F.tid); } }
    if (PH_ON) { FRAME();
        { pg8::Gemm g{wsp<bf16>(F, WS_UC), wsp<bf16>(F, WS_WOC) + (size_t)l * D * 256, TB, D, 256}; pg8::StaticOrder S; S.init(TB, D, F.G, cid);
          pg8::EpiMerge<2> E{wsp<bf16>(F, WS_G), 2048, wsp<float>(F, WS_MRG), wsp<bf16>(F, WS_MRGB)}; pg8::gemm_phase<pg8::EpiMerge<2>, pg8::StaticOrder, true, true>(ring, g, S, E, F.tid); } }
    PH_END;
    if (PH_ON) { FRAME(); const size_t r0 = (size_t)b * TB;
        pg8::Gemm g{wsp<bf16>(F, WS_MRGB), wsp<bf16>(F, WS_WOUT) + (size_t)l * D * D, TB, D, D}; pg8::StaticOrder S; S.init(TB, D, F.G, cid);
        pg8::EpiResid E{(l == 0 ? F.in(0) : (const float*)F.out) + r0 * D, F.out + r0 * D, ALPHA}; pg8::gemm_phase<pg8::EpiResid, pg8::StaticOrder, true, true>(ring, g, S, E, F.tid); }
    PH_END;
    if (PH_ON) { FRAME(); phase_ln(F, b * TB, TB, F.in(22) + l * D, F.in(23) + l * D); }
    PH_END;
}
template <int ch> __device__ __forceinline__ void moe_chunk_phases(const KState& K, int& pid) {
    if (PH_ON) { FRAME(); const int* BLKE = wsp<int>(F, WS_BLKE); int nb = BLKE[NBLK_MAX] - ch * MOE_CH; nb = nb < 0 ? 0 : (nb > MOE_CH ? MOE_CH : nb);
        if (nb > 0) { pg8::Gemm g{wsp<bf16>(F, WS_XG), wsp<bf16>(F, WS_MOEWGU), nb * 256, 2 * DFF, D}; pg8::MoeOrder S; S.init(nb * 256, 2 * DFF, F.G, cid); S.blk0 = ch * MOE_CH; S.blke = BLKE;
            pg8::EpiSwiglu E{wsp<bf16>(F, WS_HCH) - (size_t)ch * MOE_CH * 256 * DFF, DFF}; pg8::gemm_phase<pg8::EpiSwiglu, pg8::MoeOrder, true, true>(ring, g, S, E, F.tid); } }
    PH_END;
    if (PH_ON) { FRAME(); const int* BLKE = wsp<int>(F, WS_BLKE); int nb = BLKE[NBLK_MAX] - ch * MOE_CH; nb = nb < 0 ? 0 : (nb > MOE_CH ? MOE_CH : nb);
        if (nb > 0) { pg8::Gemm g{wsp<bf16>(F, WS_HCH) - (size_t)ch * MOE_CH * 256 * DFF, wsp<bf16>(F, WS_MOEWD), nb * 256, D, DFF}; pg8::MoeOrder S; S.init(nb * 256, D, F.G, cid); S.blk0 = ch * MOE_CH; S.blke = BLKE;
            pg8::EpiBf16 E{wsp<bf16>(F, WS_XG), D}; pg8::gemm_phase<pg8::EpiBf16, pg8::MoeOrder, true, true>(ring, g, S, E, F.tid); } }
    PH_END;
}
__global__ void __launch_bounds__(NWAVES * 64, 2) fwd(Args args) {
    extern __shared__ __attribute__((aligned(16))) unsigned char lds[];
    KState K;
    K.L = (LAS unsigned char*)lds; K.ws = args.ws; K.out = args.out; K.lo = args.ph_lo; K.hi = args.ph_hi;
    volatile LAS unsigned* MISC = (volatile LAS unsigned*)(K.L + MISC_OFF);
    K.wave_s = __builtin_amdgcn_readfirstlane((int)threadIdx.x >> 6);
    for (int u = K.wave_s * 64 + lane_id(); u < (LDS_BYTES - RING_BYTES) / 4; u += NWAVES * 64) ((LAS unsigned*)(K.L + RING_BYTES))[u] = 0u;
    __syncthreads();
    unsigned* const barw = (unsigned*)(args.ws + WS_CTL) + CW_BAR;
    K.bar.bar = barw; K.bar.x = 0; K.bar.st = nullptr;
    if (K.hi - K.lo > 1) K.bar = xcd_barrier_post(barw, MISC + 8, K.wave_s == 0 && lane_id() == 0);
    int pid = 0;

    if (PH_ON) { FRAME(); p0_prologue(F); }
    PH_END;
    mixer_phases<0, 0>(K, pid);
    mixer_phases<0, 1>(K, pid);
    {
        if (PH_ON) { FRAME(); pg8::Gemm g{wsp<bf16>(F, WS_XB), wsp<bf16>(F, WS_WGU), M, 2 * DFF, D}; pg8::StaticOrder S; S.init(M, 2 * DFF, F.G, cid);
            pg8::EpiSwiglu E{wsp<bf16>(F, WS_H), DFF}; pg8::gemm_phase<pg8::EpiSwiglu, pg8::StaticOrder, true, true>(ring, g, S, E, F.tid); }
        PH_END;
        if (PH_ON) { FRAME(); pg8::Gemm g{wsp<bf16>(F, WS_H), wsp<bf16>(F, WS_WD), M, D, DFF}; pg8::StaticOrder S; S.init(M, D, F.G, cid);
            pg8::EpiResid E{F.out, F.out, ALPHA}; pg8::gemm_phase<pg8::EpiResid, pg8::StaticOrder, true, true>(ring, g, S, E, F.tid); }
        PH_END;
        if (PH_ON) { FRAME(); phase_ln(F, 0, M, F.in(31), F.in(32)); }
        PH_END;
    }
    mixer_phases<1, 0>(K, pid);
    mixer_phases<1, 1>(K, pid);
    {
        if (PH_ON) { FRAME(); moe_weights(F); __syncthreads(); phase_router(F); }
        PH_END;
        if (PH_ON) { FRAME(); phase_assign(F); }
        PH_END;
        moe_chunk_phases<0>(K, pid); moe_chunk_phases<1>(K, pid); moe_chunk_phases<2>(K, pid); moe_chunk_phases<3>(K, pid); moe_chunk_phases<4>(K, pid);
        if (PH_ON) { FRAME(); phase_combine(F, F.in(31) + D, F.in(32) + D); }
        PH_END;
    }
}
#undef PH_ON
#undef PH_END
#undef FRAME

extern "C" void kernel_launch(void* const* d_in, const int* in_sizes, int n_in, void* d_out, int out_size, void* d_ws, size_t ws_size, hipStream_t stream) {
    static int grid = 0;
    if (grid == 0) {
        if (n_in != 33 || in_sizes[0] != M * D || out_size != M * D || ws_size < WS_END) { fprintf(stderr, "kernel_launch: unexpected shapes / workspace (n_in %d, ws %zu)\n", n_in, ws_size); grid = -1; return; }
        int dev = 0, cus = 0, per_cu = 0;
        if (hipGetDevice(&dev) != hipSuccess || hipDeviceGetAttribute(&cus, hipDeviceAttributeMultiprocessorCount, dev) != hipSuccess) { grid = -1; return; }
        if (hipFuncSetAttribute((const void*)fwd, hipFuncAttributeMaxDynamicSharedMemorySize, LDS_BYTES) != hipSuccess) { fprintf(stderr, "kernel_launch: hipFuncSetAttribute failed\n"); grid = -1; return; }
        if (hipOccupancyMaxActiveBlocksPerMultiprocessor(&per_cu, (const void*)fwd, NWAVES * 64, LDS_BYTES) != hipSuccess || per_cu < 1) fprintf(stderr, "kernel_launch: occupancy query reports %d\n", per_cu);
        (void)hipGetLastError();
        grid = cus;
    }
    if (grid < 0) return;
    if (hipMemsetAsync((char*)d_ws + WS_CTL, 0, CTL_ZERO_BYTES, stream) != hipSuccess) return;
    Args a{};
    for (int i = 0; i < 33; ++i) a.in[i] = (const float*)d_in[i];
    a.out = (float*)d_out; a.ws = (unsigned char*)d_ws;
#if MK_ONE_LAUNCH
    a.ph_lo = 0; a.ph_hi = NPH;
    hipLaunchKernelGGL(fwd, dim3(grid), dim3(NWAVES * 64), LDS_BYTES, stream, a);
#else
    for (int p = 0; p < NPH; ++p) { a.ph_lo = p; a.ph_hi = p + 1; hipLaunchKernelGGL(fwd, dim3(grid), dim3(NWAVES * 64), LDS_BYTES, stream, a); }
#endif
}
```
